# Optimizing an MI355X kernel written in HIP

```python
import jax
import jax.numpy as jnp
from jax import lax
import numpy as np

D_MODEL = 1024
BATCH = 16
SEQ = 256
DEPTH = 2
DEC_BATCH = 2
DEC_SEQ = 4096
PAST_LEN = 512

GRID_W = 64
HEAD_DIM = 64
N_RET_HEADS = 8
N_NA_HEADS = 8
RET_WIDTH = N_RET_HEADS * HEAD_DIM
NA_WIDTH = N_NA_HEADS * HEAD_DIM
MIX_WIDTH = RET_WIDTH + NA_WIDTH
IN_WIDTH = 4 * RET_WIDTH + 3 * NA_WIDTH
D_FF = 2816
CONV_W = 3
CHUNK = 128
NA_KH_MAX = 8
NA_KW = 16
NA_QB = 16
NA_KB = 2 * NA_KW
ATTN_QBLOCK = 128
ROPE_BASE = 10000.0
EPS = 1e-6
NEG_INF = -1e9

kernel_name = "hymba_retention_natten_prefix_dit"


def _rmsnorm(x, g):
    xf = x.astype(jnp.float32)
    y = xf * lax.rsqrt(jnp.mean(xf * xf, axis=-1, keepdims=True) + EPS)
    return (y * g.astype(jnp.float32)).astype(x.dtype)


def _modulation(cond, ada_w, ada_b):
    m = jax.nn.silu(cond) @ ada_w + ada_b
    return jnp.split(m[:, None, :], 6, axis=-1)


def _split_proj(h, w_in):
    B, T, _ = h.shape
    p = h @ w_in
    cuts = [RET_WIDTH, 2 * RET_WIDTH, 3 * RET_WIDTH, 4 * RET_WIDTH,
            4 * RET_WIDTH + NA_WIDTH, 4 * RET_WIDTH + 2 * NA_WIDTH]
    rq, rk, rv, rg, nq, nk, nv = jnp.split(p, cuts, axis=-1)
    hr = lambda a: a.reshape(B, T, N_RET_HEADS, HEAD_DIM)
    hn = lambda a: a.reshape(B, T, N_NA_HEADS, HEAD_DIM)
    return hr(rq), hr(rk), hr(rv), rg, hn(nq), hn(nk), hn(nv)


def _rotate(x, pos):
    d = x.shape[-1]
    inv = jnp.power(ROPE_BASE, -jnp.arange(0, d, 2, dtype=jnp.float32) / d)
    ang = pos[:, None] * inv[None, :]
    cos = jnp.cos(ang)[None, :, None, :]
    sin = jnp.sin(ang)[None, :, None, :]
    xf = x.astype(jnp.float32)
    x1, x2 = xf[..., : d // 2], xf[..., d // 2:]
    return jnp.concatenate([x1 * cos - x2 * sin, x1 * sin + x2 * cos], axis=-1).astype(x.dtype)


def _rope_2d(x):
    T = x.shape[1]
    pos = jnp.arange(T)
    rows = (pos // GRID_W).astype(jnp.float32)
    cols = (pos % GRID_W).astype(jnp.float32)
    half = x.shape[-1] // 2
    return jnp.concatenate([_rotate(x[..., :half], rows), _rotate(x[..., half:], cols)], axis=-1)


def _retention_scan(q, k, v, log_gamma, s0):
    B, T, H, Dh = q.shape
    nc = T // CHUNK
    lg = log_gamma.astype(jnp.float32)
    pos = jnp.arange(CHUNK, dtype=jnp.float32)
    diff = pos[:, None] - pos[None, :]
    decay_in = jnp.where(diff >= 0, jnp.exp(lg[:, None, None] * jnp.maximum(diff, 0.0)), 0.0)
    q_dec = jnp.exp(lg[None, :] * (pos[:, None] + 1.0))
    k_dec = jnp.exp(lg[None, :] * (CHUNK - 1.0 - pos[:, None]))
    c_dec = jnp.exp(lg * CHUNK)

    def to_chunks(a):
        return a.astype(jnp.float32).reshape(B, nc, CHUNK, H, Dh).transpose(1, 0, 2, 3, 4)

    def step(s, qkv):
        qc, kc, vc = qkv
        scores = jnp.einsum('bihd,bjhd->bhij', qc, kc) * decay_in[None]
        inner = jnp.einsum('bhij,bjhe->bihe', scores, vc)
        cross = jnp.einsum('bihd,bhde->bihe', qc, s) * q_dec[None, :, :, None]
        s_new = s * c_dec[None, :, None, None] + jnp.einsum(
            'bjhd,bjhe->bhde', kc * k_dec[None, :, :, None], vc)
        return s_new, inner + cross

    s_fin, out = lax.scan(step, s0.astype(jnp.float32), (to_chunks(q), to_chunks(k), to_chunks(v)))
    out = out.transpose(1, 0, 2, 3, 4).reshape(B, T, H, Dh)
    return out, s_fin


def _bi_retention(q, k, v, g, lg_f, lg_b, s_f0, s_b0):
    B, T = q.shape[0], q.shape[1]
    q = q * (HEAD_DIM ** -0.5)
    o_f, s_f = _retention_scan(q, k, v, lg_f, s_f0)
    o_b, s_b = _retention_scan(jnp.flip(q, 1), jnp.flip(k, 1), jnp.flip(v, 1), lg_b, s_b0)
    o = o_f + jnp.flip(o_b, 1)
    mu = jnp.mean(o, axis=-1, keepdims=True)
    var = jnp.mean(jnp.square(o - mu), axis=-1, keepdims=True)
    o = ((o - mu) * lax.rsqrt(var + EPS)).reshape(B, T, RET_WIDTH).astype(g.dtype)
    return o * jax.nn.silu(g), s_f, s_b


def _context_attention(q, k, v):
    B, N, H, Dh = q.shape
    nb = N // ATTN_QBLOCK
    qb = q.reshape(B, nb, ATTN_QBLOCK, H, Dh).transpose(1, 0, 2, 3, 4)
    scale = HEAD_DIM ** -0.5

    def blk(qi):
        s = jnp.einsum('bqhd,bkhd->bhqk', qi, k).astype(jnp.float32) * scale
        p = jax.nn.softmax(s, axis=-1)
        return jnp.einsum('bhqk,bkhd->bqhd', p.astype(v.dtype), v)

    out = lax.map(blk, qb)
    return out.transpose(1, 0, 2, 3, 4).reshape(B, N, H * Dh)


def _neighbourhood_attention(q, k, v, ctx_k, ctx_v, rpb):
    B, T, H, Dh = q.shape
    rows = T // GRID_W
    kh = min(NA_KH_MAX, rows)
    ncb = GRID_W // NA_QB
    r = np.arange(rows)
    rs = np.clip(r - kh // 2, 0, rows - kh)
    row_idx = rs[:, None] + np.arange(kh)[None, :]
    dr_idx = row_idx - r[:, None] + NA_KH_MAX - 1
    jb = np.arange(ncb)
    kb = np.clip(jb * NA_QB - NA_KW // 2, 0, GRID_W - NA_KB)
    col_idx = kb[:, None] + np.arange(NA_KB)[None, :]
    qcol = jb[:, None] * NA_QB + np.arange(NA_QB)[None, :]
    cs = np.clip(qcol - NA_KW // 2, 0, GRID_W - NA_KW)
    col_ok = (col_idx[:, None, :] >= cs[:, :, None]) & (col_idx[:, None, :] < cs[:, :, None] + NA_KW)
    dc_idx = np.clip(col_idx[:, None, :] - qcol[:, :, None] + NA_KW - 1, 0, 2 * NA_KW - 2)
    L = kh * NA_KB
    scale = HEAD_DIM ** -0.5

    k_grid = k.reshape(B, rows, GRID_W, H, Dh)
    v_grid = v.reshape(B, rows, GRID_W, H, Dh)
    q_rows = q.reshape(B, rows, ncb, NA_QB, H, Dh).transpose(1, 0, 2, 3, 4, 5)
    rpb_f = rpb.astype(jnp.float32)

    def gather_rows(grid, ridx):
        g = grid[:, ridx][:, :, col_idx]
        return g.transpose(0, 2, 1, 3, 4, 5).reshape(B, ncb, L, H, Dh)

    def row_block(args):
        qr, ridx, dri = args
        kr = gather_rows(k_grid, ridx)
        vr = gather_rows(v_grid, ridx)
        bias = rpb_f[:, dri[None, None, :, None], dc_idx[:, :, None, :]]
        bias = jnp.where(col_ok[None, :, :, None, :], bias, NEG_INF).reshape(H, ncb, NA_QB, L)
        s_loc = jnp.einsum('bjqhd,bjlhd->bhjql', qr, kr).astype(jnp.float32) * scale + bias[None]
        s_ctx = jnp.einsum('bjqhd,bnhd->bhjqn', qr, ctx_k).astype(jnp.float32) * scale
        p = jax.nn.softmax(jnp.concatenate([s_loc, s_ctx], axis=-1), axis=-1)
        o = jnp.einsum('bhjql,bjlhd->bjqhd', p[..., :L].astype(vr.dtype), vr)
        o = o + jnp.einsum('bhjqn,bnhd->bjqhd', p[..., L:].astype(ctx_v.dtype), ctx_v)
        return o

    out = lax.map(row_block, (q_rows, jnp.asarray(row_idx, jnp.int32), jnp.asarray(dr_idx, jnp.int32)))
    return out.transpose(1, 0, 2, 3, 4, 5).reshape(B, T, H * Dh)


def _conv_ffn(h, w_up, conv_w, conv_b, w_down):
    T = h.shape[1]
    u = h @ w_up
    pad = CONV_W // 2
    up = jnp.pad(u, ((0, 0), (pad, pad), (0, 0)))
    u = sum(up[:, i:i + T] * conv_w[i] for i in range(CONV_W)) + conv_b
    a, gate = jnp.split(u, 2, axis=-1)
    return (jax.nn.silu(gate) * a) @ w_down


def _context_mixer(parts, lg_f, lg_b):
    rq, rk, rv, rg, nq, nk, nv = parts
    B = rq.shape[0]
    z = jnp.zeros((B, N_RET_HEADS, HEAD_DIM, HEAD_DIM), jnp.float32)
    ret, s_f, s_b = _bi_retention(rq, rk, rv, rg, lg_f, lg_b, z, z)
    na = _context_attention(nq, nk, nv)
    return jnp.concatenate([ret, na], axis=-1), (nk, nv, s_f, s_b)


def _latent_mixer(parts, lg_f, lg_b, rpb, ctx_k, ctx_v, s_f0, s_b0):
    rq, rk, rv, rg, nq, nk, nv = parts
    rq = _rope_2d(rq)
    rk = _rope_2d(rk)
    ret, _, _ = _bi_retention(rq, rk, rv, rg, lg_f, lg_b, s_f0, s_b0)
    na = _neighbourhood_attention(nq, nk, nv, ctx_k, ctx_v, rpb)
    return jnp.concatenate([ret, na], axis=-1), None


def _layer(x, cond, mixer, ada_w, ada_b, g_pre_mix, g_post_mix, g_pre_ffn, g_post_ffn,
           w_in, w_out, w_up, conv_w, conv_b, w_down):
    sh1, sc1, ga1, sh2, sc2, ga2 = _modulation(cond, ada_w, ada_b)
    h = _rmsnorm(x, g_pre_mix) * (1.0 + sc1) + sh1
    mixed, side = mixer(_split_proj(h, w_in))
    x = x + ga1 * _rmsnorm(mixed @ w_out, g_post_mix)
    h = _rmsnorm(x, g_pre_ffn) * (1.0 + sc2) + sh2
    x = x + ga2 * _rmsnorm(_conv_ffn(h, w_up, conv_w, conv_b, w_down), g_post_ffn)
    return x, side


def setup_inputs(seed: int = 0) -> dict:
    key = jax.random.key(seed)
    ks = jax.random.split(key, 24)
    f32 = jnp.float32

    def nrm(k, shape, scale):
        return scale * jax.random.normal(k, shape, f32)

    decay_base = jnp.log(jnp.power(2.0, 5.0 + jnp.arange(N_RET_HEADS, dtype=f32)) - 1.0)
    return {
        'x_prompt': nrm(ks[0], (BATCH, SEQ, D_MODEL), 1.0),
        'x_sample': nrm(ks[1], (DEC_BATCH, DEC_SEQ, D_MODEL), 1.0),
        'c': nrm(ks[2], (DEC_BATCH, D_MODEL), 1.0),
        'cache_na_k': nrm(ks[3], (DEC_BATCH, DEPTH, PAST_LEN, N_NA_HEADS, HEAD_DIM), 1.0),
        'cache_na_v': nrm(ks[4], (DEC_BATCH, DEPTH, PAST_LEN, N_NA_HEADS, HEAD_DIM), 1.0),
        'state_ret_fwd': nrm(ks[5], (DEC_BATCH, DEPTH, N_RET_HEADS, HEAD_DIM, HEAD_DIM), 0.5),
        'state_ret_bwd': nrm(ks[6], (DEC_BATCH, DEPTH, N_RET_HEADS, HEAD_DIM, HEAD_DIM), 0.5),
        'c_ctx': nrm(ks[7], (D_MODEL,), 1.0),
        'ada_w': nrm(ks[8], (DEPTH, D_MODEL, 6 * D_MODEL), 0.5 * D_MODEL ** -0.5),
        'ada_b': nrm(ks[9], (DEPTH, 6 * D_MODEL), 0.02),
        'g_pre_mix': 1.0 + nrm(ks[10], (DEPTH, D_MODEL), 0.05),
        'g_post_mix': 1.0 + nrm(ks[11], (DEPTH, D_MODEL), 0.05),
        'g_pre_ffn': 1.0 + nrm(ks[12], (DEPTH, D_MODEL), 0.05),
        'g_post_ffn': 1.0 + nrm(ks[13], (DEPTH, D_MODEL), 0.05),
        'w_in': nrm(ks[14], (DEPTH, D_MODEL, IN_WIDTH), D_MODEL ** -0.5),
        'ret_decay_fwd': decay_base + nrm(ks[15], (DEPTH, N_RET_HEADS), 0.1),
        'ret_decay_bwd': decay_base + nrm(ks[16], (DEPTH, N_RET_HEADS), 0.1),
        'na_rpb': nrm(ks[17], (DEPTH, N_NA_HEADS, 2 * NA_KH_MAX - 1, 2 * NA_KW - 1), 0.5),
        'w_out': nrm(ks[18], (DEPTH, MIX_WIDTH, D_MODEL), MIX_WIDTH ** -0.5),
        'w_up': nrm(ks[19], (DEPTH, D_MODEL, 2 * D_FF), D_MODEL ** -0.5),
        'conv_w': nrm(ks[20], (DEPTH, CONV_W, 2 * D_FF), CONV_W ** -0.5),
        'conv_b': nrm(ks[21], (DEPTH, 2 * D_FF), 0.02),
        'w_down': nrm(ks[22], (DEPTH, D_FF, D_MODEL), D_FF ** -0.5),
    }


def reference(x_prompt, x_sample, c, cache_na_k, cache_na_v, state_ret_fwd, state_ret_bwd, c_ctx,
              ada_w, ada_b, g_pre_mix, g_post_mix, g_pre_ffn, g_post_ffn, w_in,
              ret_decay_fwd, ret_decay_bwd, na_rpb, w_out, w_up, conv_w, conv_b, w_down):
    y_p = x_prompt
    ks_, vs_, sfs_, sbs_ = [], [], [], []
    for l in range(DEPTH):
        lg_f = jax.nn.log_sigmoid(ret_decay_fwd[l].astype(jnp.float32))
        lg_b = jax.nn.log_sigmoid(ret_decay_bwd[l].astype(jnp.float32))
        mixer = lambda parts, lg_f=lg_f, lg_b=lg_b: _context_mixer(parts, lg_f, lg_b)
        y_p, (k_l, v_l, sf_l, sb_l) = _layer(
            y_p, c_ctx[None, :], mixer, ada_w[l], ada_b[l], g_pre_mix[l], g_post_mix[l],
            g_pre_ffn[l], g_post_ffn[l], w_in[l], w_out[l], w_up[l], conv_w[l], conv_b[l], w_down[l])
        ks_.append(k_l)
        vs_.append(v_l)
        sfs_.append(sf_l.astype(x_prompt.dtype))
        sbs_.append(sb_l.astype(x_prompt.dtype))

    y_s = x_sample
    for l in range(DEPTH):
        lg_f = jax.nn.log_sigmoid(ret_decay_fwd[l].astype(jnp.float32))
        lg_b = jax.nn.log_sigmoid(ret_decay_bwd[l].astype(jnp.float32))
        mixer = (lambda parts, lg_f=lg_f, lg_b=lg_b, rpb=na_rpb[l], ck=cache_na_k[:, l], cv=cache_na_v[:, l],
                 sf0=state_ret_fwd[:, l], sb0=state_ret_bwd[:, l]:
                 _latent_mixer(parts, lg_f, lg_b, rpb, ck, cv, sf0, sb0))
        y_s, _ = _layer(
            y_s, c, mixer, ada_w[l], ada_b[l], g_pre_mix[l], g_post_mix[l],
            g_pre_ffn[l], g_post_ffn[l], w_in[l], w_out[l], w_up[l], conv_w[l], conv_b[l], w_down[l])

    new_na_k = jnp.stack(ks_, axis=1)
    new_na_v = jnp.stack(vs_, axis=1)
    new_ret_fwd = jnp.stack(sfs_, axis=1)
    new_ret_bwd = jnp.stack(sbs_, axis=1)
    return (y_p, y_s, new_na_k, new_na_v, new_ret_fwd, new_ret_bwd)
```

```cpp
#include <hip/hip_runtime.h>
#include <cstdio>
#include <cstdint>

#define LAS __attribute__((address_space(3)))
typedef unsigned short bf16;
typedef short bf16x8 __attribute__((ext_vector_type(8)));
typedef float f32x4 __attribute__((ext_vector_type(4)));
typedef unsigned u32x4 __attribute__((ext_vector_type(4)));

constexpr int DM = 1024, M_CTX = 4096, M_LAT = 8192, MROWS = 12288;
constexpr int T_CTX = 256, T_LAT = 4096, NB_CTX = 16, NB_LAT = 2;
constexpr int NIN = 3584, NUP = 5632, NFF = 2816, NH = 8, HD = 64, NLAYER = 2, PAST = 512;
constexpr int C_RQ = 0, C_RK = 512, C_RV = 1024, C_RG = 1536, C_NQ = 2048, C_NK = 2560, C_NV = 3072;
constexpr float EPS = 1e-6f, LOG2E = 1.4426950408889634f;
constexpr size_t O_YP = 0, O_YS = 4194304, O_NK = 12582912, O_NV = 16777216, O_RF = 20971520, O_RB = 22020096;
constexpr size_t MiB = 1u << 20;
constexpr size_t WS_CTL = 0, CTL_BYTES = 1 * MiB;
constexpr size_t WS_MOD = 256 * 1024;
constexpr size_t WS_W = 1 * MiB;
constexpr size_t W_IN_OFF = 0, W_OUT_OFF = (size_t)NIN * DM * 2, W_UP_OFF = W_OUT_OFF + (size_t)DM * DM * 2, W_DOWN_OFF = W_UP_OFF + (size_t)NUP * DM * 2,
                 W_LAYER_BYTES = W_DOWN_OFF + (size_t)DM * NFF * 2;
static_assert(WS_W + 2 * W_LAYER_BYTES <= 52 * MiB, "weights");
constexpr size_t WS_HA = 52 * MiB;
constexpr size_t WS_BIG = 118 * MiB;
constexpr size_t BIG_MIX_OFF = 84 * MiB;
constexpr size_t WS_END = 250 * MiB;

__device__ __forceinline__ unsigned f2bf(float f) { unsigned u = __builtin_bit_cast(unsigned, f); return (u + 0x7fffu + ((u >> 16) & 1u)) >> 16; }
__device__ __forceinline__ float bf2f(bf16 h) { return __builtin_bit_cast(float, (unsigned)h << 16); }
__device__ __forceinline__ float silu_f(float x) { return x / (1.f + __expf(-x)); }
__device__ __forceinline__ float wave_sum(float v) {
#pragma unroll
    for (int o = 1; o < 64; o <<= 1) v += __shfl_xor(v, o);
    return v;
}
__device__ __forceinline__ float wave_max(float v) {
#pragma unroll
    for (int o = 1; o < 64; o <<= 1) v = fmaxf(v, __shfl_xor(v, o));
    return v;
}
__device__ __forceinline__ int cond_of_row(int row) { return row < M_CTX ? 0 : 1 + ((row - M_CTX) >> 12); }
__device__ __forceinline__ float log_sigmoid_f(float x) { return -log1pf(expf(-x)); }

namespace pg8 {
#define PG8_LAS __attribute__((address_space(3)))
typedef unsigned short bf16_t;
typedef short bf16x8 __attribute__((ext_vector_type(8)));
typedef float f32x4 __attribute__((ext_vector_type(4)));
typedef unsigned u32x4 __attribute__((ext_vector_type(4)));
constexpr int BM = 256, BK = 64, HALF = 128, HTB = HALF * BK * 2  , STAGE_BYTES = 8 * HTB, NXCD = 8, WGM = 8;

__host__ __device__ __forceinline__ int lds_byte(int r, int c) { const int st = (r >> 4) * 2 + (c >> 5), rr = r & 15, cc = c & 31, ob = rr * 64 + cc * 2; return st * 1024 + (ob ^ (((ob >> 9) & 1) << 5)); }
__host__ __device__ __forceinline__ void stage_rc(int b, int& R, int& C) { const int st = b / 1024, sb = b % 1024, swz = sb ^ (((sb >> 9) & 1) << 5); R = (st >> 1) * 16 + swz / 64; C = (st & 1) * 32 + (swz % 64) / 2; }
__host__ __device__ __forceinline__ int perm32(int rho) { const int n = rho >> 4, i = rho & 15; return 8 * (i >> 2) + 4 * n + (i & 3); }

struct Unit { int pm, pn; };
struct Gemm { const bf16_t* A; const bf16_t* Bt; int M, N, K; };

struct StaticOrder {
    int nM, nN, nwg, G, c;
    __host__ __device__ void init(int M, int N, int G_, int c_) { nM = M / BM; nN = N / BM; nwg = nM * nN; G = G_; c = c_; }
    __host__ __device__ bool next(int i, Unit& u) const {
        const long L = (long)i * G + c; if (L >= nwg) return false;
        int wgid = (int)L; { const int q = nwg / NXCD, r = nwg % NXCD, xcd = wgid % NXCD, off = wgid / NXCD; wgid = (xcd < r ? xcd * (q + 1) : r * (q + 1) + (xcd - r) * q) + off; }
        const int nig = WGM * nN, gid = wgid / nig, fm = gid * WGM, gsz = (nM - fm) < WGM ? (nM - fm) : WGM;
        u.pm = fm + ((wgid % nig) % gsz); u.pn = (wgid % nig) / gsz; return true;
    }
    __device__ __forceinline__ void a_ready(const Unit&) const {}
    __device__ __forceinline__ void done(const Unit&) const {}
};

__device__ __forceinline__ unsigned cvt_pk_bf16(float lo, float hi) { unsigned r; asm volatile("v_cvt_pk_bf16_f32 %0, %1, %2" : "=v"(r) : "v"(lo), "v"(hi)); return r; }
typedef float f32x2 __attribute__((ext_vector_type(2)));
template <class Epi, class Sched, bool ALIGN_EPI = false, bool SP2 = false>
__device__ __forceinline__ void gemm_phase(PG8_LAS unsigned char* lds, const Gemm g, const Sched& S, const Epi& E, const int tid_in) {
    const int tid = tid_in, wid = __builtin_amdgcn_readfirstlane(tid >> 6), lane = tid & 63, wr = wid >> 2, wc = wid & 3, fr = lane & 15, fq = lane >> 4;
    const int K = g.K, nt = K / BK;
    unsigned voffA[2], voffB[2];
#pragma unroll
    for (int i = 0; i < 2; ++i) { int R, C; stage_rc(tid * 16 + i * 8192, R, C); const int Rb = Epi::PERM ? ((R & ~31) + perm32(R & 31)) : R;
        voffA[i] = (unsigned)(R * K + C) * 2u; voffB[i] = (unsigned)(Rb * K + C) * 2u; }
    const size_t kstep = (size_t)(BK * 2);
    const size_t hstep = (size_t)HALF * K * 2;
    const size_t tstep = 2 * hstep;
    const unsigned ldsw = (unsigned)wid * 1024u;
    const int aoff = lds_byte(wr * 64 + fr, fq * 8), boff = lds_byte(wc * 32 + fr, fq * 8);
#define PG8_SA(b, h) (((b) * 2 + (h)) * HTB)
#define PG8_SB(b, h) ((4 + (b) * 2 + (h)) * HTB)
#define PG8_STAGE(bufoff, gbase, voff) do { _Pragma("unroll") for (int _i = 0; _i < 2; ++_i) \
        __builtin_amdgcn_global_load_lds((const unsigned*)((const char*)(gbase) + (voff)[_i]), (PG8_LAS unsigned*)(lds + (bufoff) + ldsw + _i * 8192), 16, 0, 0); } while (0)
#define PG8_LDA(dst, b, h) do { _Pragma("unroll") for (int m = 0; m < 4; ++m) _Pragma("unroll") for (int k = 0; k < 2; ++k) dst[m][k] = *(const PG8_LAS bf16x8*)(lds + PG8_SA(b, h) + aoff + m * 2048 + k * 1024); } while (0)
#define PG8_LDB(dst, b, h) do { _Pragma("unroll") for (int n = 0; n < 2; ++n) _Pragma("unroll") for (int k = 0; k < 2; ++k) dst[n][k] = *(const PG8_LAS bf16x8*)(lds + PG8_SB(b, h) + boff + n * 2048 + k * 1024); } while (0)
#define PG8_MMA(ai, bj, At, Bt) do { __builtin_amdgcn_s_setprio(1); _Pragma("unroll") for (int m = 0; m < 4; ++m) _Pragma("unroll") for (int n = 0; n < 2; ++n) _Pragma("unroll") for (int k = 0; k < 2; ++k) \
        acc[ai][bj][m][n] = __builtin_amdgcn_mfma_f32_16x16x32_bf16(Bt[n][k], At[m][k], acc[ai][bj][m][n], 0, 0, 0); __builtin_amdgcn_s_setprio(0); } while (0)
#define PG8_WAIT_V(n) asm volatile("s_waitcnt vmcnt(" #n ")" ::: "memory")
#define PG8_WAIT_L(n) asm volatile("s_waitcnt lgkmcnt(" #n ")" ::: "memory")
#define PG8_BAR __builtin_amdgcn_s_barrier()
#define PG8_SCHED __builtin_amdgcn_sched_barrier(0)
    Unit cur, nxt; int ui = 0;
    if (!S.next(0, cur)) return;
    f32x4 acc[2][2][4][2];
#pragma unroll
    for (int a = 0; a < 2; ++a)
#pragma unroll
        for (int b = 0; b < 2; ++b)
#pragma unroll
            for (int m = 0; m < 4; ++m)
#pragma unroll
                for (int n = 0; n < 2; ++n) acc[a][b][m][n] = (f32x4){0.f, 0.f, 0.f, 0.f};
    bf16x8 At[4][2], B0[2][2], B1[2][2];
    const char* cA = (const char*)g.A + (size_t)cur.pm * tstep; const char* cB = (const char*)g.Bt + (size_t)cur.pn * tstep;
    S.a_ready(cur);
    if constexpr (SP2) {
        PG8_STAGE(PG8_SB(0, 0), cB, voffB); PG8_STAGE(PG8_SB(0, 1), cB + hstep, voffB); PG8_STAGE(PG8_SA(0, 0), cA, voffA); PG8_STAGE(PG8_SA(0, 1), cA + hstep, voffA);
        if (wr == 1) PG8_BAR;
        PG8_WAIT_V(2); PG8_BAR;
        PG8_STAGE(PG8_SB(1, 0), cB + kstep, voffB); PG8_STAGE(PG8_SA(1, 0), cA + kstep, voffA); PG8_STAGE(PG8_SB(1, 1), cB + hstep + kstep, voffB);
        PG8_WAIT_V(6); PG8_BAR;
    } else {
        PG8_STAGE(PG8_SB(0, 0), cB, voffB); PG8_STAGE(PG8_SA(0, 0), cA, voffA); PG8_STAGE(PG8_SB(0, 1), cB + hstep, voffB); PG8_STAGE(PG8_SA(0, 1), cA + hstep, voffA);
        if (wr == 1) PG8_BAR;
        PG8_WAIT_V(4); PG8_BAR;
        PG8_STAGE(PG8_SB(1, 0), cB + kstep, voffB); PG8_STAGE(PG8_SA(1, 0), cA + kstep, voffA); PG8_STAGE(PG8_SB(1, 1), cB + hstep + kstep, voffB);
        PG8_WAIT_V(6); PG8_BAR;
    }
    for (;;) {
        const bool has_next = S.next(ui + 1, nxt);
        const char* nA = has_next ? (const char*)g.A + (size_t)nxt.pm * tstep : cA; const char* nB = has_next ? (const char*)g.Bt + (size_t)nxt.pn * tstep : cB;
        for (int t = 0; t < nt; t += 2) {
            const bool last = (t == nt - 2);
            const char* a1 = cA + (size_t)(t + 1) * kstep;
            const char* a2 = last ? nA : cA + (size_t)(t + 2) * kstep; const char* b2 = last ? nB : cB + (size_t)(t + 2) * kstep;
            const char* a3 = a2 + kstep; const char* b3 = b2 + kstep;
            if (last && has_next) S.a_ready(nxt);
            if constexpr (SP2) {
            PG8_LDB(B0, 0, 0); PG8_LDB(B1, 0, 1); PG8_SCHED; PG8_LDA(At, 0, 0); PG8_STAGE(PG8_SA(1, 1), a1 + hstep, voffA);
            PG8_WAIT_V(8); PG8_WAIT_L(0); PG8_BAR; PG8_MMA(0, 0, At, B0); PG8_MMA(0, 1, At, B1); PG8_BAR; PG8_SCHED;
            PG8_LDA(At, 0, 1); PG8_STAGE(PG8_SB(0, 0), b2, voffB); PG8_STAGE(PG8_SB(0, 1), b2 + hstep, voffB); PG8_STAGE(PG8_SA(0, 0), a2, voffA);
            PG8_WAIT_V(8); PG8_WAIT_L(0); PG8_BAR; PG8_MMA(1, 0, At, B0); PG8_MMA(1, 1, At, B1); PG8_BAR; PG8_SCHED;
            PG8_LDB(B0, 1, 0); PG8_LDB(B1, 1, 1); PG8_SCHED; PG8_LDA(At, 1, 0); PG8_STAGE(PG8_SA(0, 1), a2 + hstep, voffA);
            PG8_WAIT_V(8); PG8_WAIT_L(0); PG8_BAR; PG8_MMA(0, 0, At, B0); PG8_MMA(0, 1, At, B1); PG8_BAR; PG8_SCHED;
            PG8_LDA(At, 1, 1); PG8_STAGE(PG8_SB(1, 0), b3, voffB); PG8_STAGE(PG8_SB(1, 1), b3 + hstep, voffB); PG8_STAGE(PG8_SA(1, 0), a3, voffA);
            PG8_WAIT_V(8); PG8_WAIT_L(0); PG8_BAR; PG8_MMA(1, 0, At, B0); PG8_MMA(1, 1, At, B1); PG8_BAR; PG8_SCHED;
            } else {
            PG8_LDB(B0, 0, 0); PG8_SCHED; PG8_LDA(At, 0, 0); PG8_STAGE(PG8_SA(1, 1), a1 + hstep, voffA);
            PG8_WAIT_L(8); PG8_BAR; PG8_WAIT_L(0); PG8_MMA(0, 0, At, B0); PG8_BAR; PG8_SCHED;
            PG8_LDB(B1, 0, 1); PG8_STAGE(PG8_SB(0, 0), b2, voffB);
            PG8_BAR; PG8_WAIT_L(0); PG8_MMA(0, 1, At, B1); PG8_BAR;
            PG8_LDA(At, 0, 1); PG8_STAGE(PG8_SA(0, 0), a2, voffA);
            PG8_BAR; PG8_WAIT_L(0); PG8_MMA(1, 0, At, B0); PG8_BAR; PG8_SCHED;
            PG8_STAGE(PG8_SB(0, 1), b2 + hstep, voffB);
            PG8_WAIT_V(6); PG8_BAR; PG8_MMA(1, 1, At, B1); PG8_BAR;
            PG8_LDB(B0, 1, 0); PG8_SCHED; PG8_LDA(At, 1, 0); PG8_STAGE(PG8_SA(0, 1), a2 + hstep, voffA);
            PG8_WAIT_L(8); PG8_BAR; PG8_WAIT_L(0); PG8_MMA(0, 0, At, B0); PG8_BAR; PG8_SCHED;
            PG8_LDB(B1, 1, 1); PG8_STAGE(PG8_SB(1, 0), b3, voffB);
            PG8_BAR; PG8_WAIT_L(0); PG8_MMA(0, 1, At, B1); PG8_BAR;
            PG8_LDA(At, 1, 1); PG8_STAGE(PG8_SA(1, 0), a3, voffA);
            PG8_BAR; PG8_WAIT_L(0); PG8_MMA(1, 0, At, B0); PG8_BAR; PG8_SCHED;
            PG8_STAGE(PG8_SB(1, 1), b3 + hstep, voffB);
            PG8_WAIT_V(6); PG8_BAR; PG8_MMA(1, 1, At, B1); PG8_BAR;
            }
        }
        if constexpr (ALIGN_EPI) { if (wr == 0) PG8_BAR; }
        if constexpr (!Epi::AFTER_DRAIN) { E(acc, cur, wr, wc, fr, fq); S.done(cur); }
        if (!has_next) break;
#pragma unroll
        for (int a = 0; a < 2; ++a)
#pragma unroll
            for (int b = 0; b < 2; ++b)
#pragma unroll
                for (int m = 0; m < 4; ++m)
#pragma unroll
                    for (int n = 0; n < 2; ++n) acc[a][b][m][n] = (f32x4){0.f, 0.f, 0.f, 0.f};
        cur = nxt; cA = nA; cB = nB; ++ui;
        if constexpr (ALIGN_EPI) { if (wr == 1) PG8_BAR; }
    }
    PG8_WAIT_V(0);
    if constexpr (!ALIGN_EPI) { if (wr == 0) PG8_BAR; }
    PG8_BAR;
    if constexpr (Epi::AFTER_DRAIN) { E.fused(acc, cur, wr, wc, fr, fq, lds, wid, lane); S.done(cur); }
#undef PG8_SA
#undef PG8_SB
#undef PG8_STAGE
#undef PG8_LDA
#undef PG8_LDB
#undef PG8_MMA
#undef PG8_WAIT_V
#undef PG8_WAIT_L
#undef PG8_BAR
#undef PG8_SCHED
}
}
#define XB_TMO      128
#define XB_XCNT(j)  (256  + 64 * (j))
#define XB_XSUB(j)  (1280 + 64 * (j))
#define XB_XGEN(j)  (2304 + 64 * (j))
#define XB_TOP      3328
#define XB_TOPGEN   3392
#define XCD_BAR_WORDS 3456
#define XB_SPIN_CAP (1u << 18)

__device__ __forceinline__ unsigned xb_ld(unsigned* p)              { return __hip_atomic_load(p, __ATOMIC_RELAXED, __HIP_MEMORY_SCOPE_AGENT); }
__device__ __forceinline__ unsigned xb_add(unsigned* p, unsigned v) { return __hip_atomic_fetch_add(p, v, __ATOMIC_RELAXED, __HIP_MEMORY_SCOPE_AGENT); }
__device__ __forceinline__ unsigned xb_xcc_id() { return (unsigned)__builtin_amdgcn_s_getreg((3 << 11) | 20) & 0xFu; }
#define XB_SPIN(cond, bar) do { unsigned _sp = 0; while (cond) { __builtin_amdgcn_s_sleep(1); \
    if ((++_sp & 255u) == 0u) { if (xb_ld(&(bar)[XB_TMO])) break; if (_sp > XB_SPIN_CAP) { atomicAdd(&(bar)[XB_TMO], 1u); break; } } } } while (0)

struct XcdBarrier {
    unsigned* bar; unsigned x;
    volatile LAS unsigned* st;
};

__device__ __forceinline__ XcdBarrier xcd_barrier_post(unsigned* bar, volatile LAS unsigned* st) {
    XcdBarrier b; b.bar = bar; b.x = xb_xcc_id(); b.st = st;
    if (threadIdx.x == 0) (void)xb_add(&bar[XB_XCNT(b.x)], 1u);
    return b;
}
__device__ __forceinline__ void xcd_barrier_complete(unsigned* bar, unsigned x, unsigned& nloc, unsigned& nx) {
    const unsigned G = gridDim.x * gridDim.y * gridDim.z;
    unsigned sum, cnt, mine, sp = 0u;
    for (;;) {
        sum = 0u; cnt = 0u; mine = 0u;
#pragma unroll
        for (unsigned j = 0; j < 16; ++j) { const unsigned c = xb_ld(&bar[XB_XCNT(j)]); sum += c; cnt += (c > 0u) ? 1u : 0u; mine = (j == x) ? c : mine; }
        if (sum == G) break;
        __builtin_amdgcn_s_sleep(1);
        if ((++sp & 255u) == 0u) { if (xb_ld(&bar[XB_TMO])) break; if (sp > XB_SPIN_CAP) { atomicAdd(&bar[XB_TMO], 1u); break; } }
    }
    nloc = mine > 0u ? mine : 1u; nx = cnt > 0u ? cnt : 1u;
}

__device__ __forceinline__ void xcd_barrier(const XcdBarrier& b) {
    asm volatile("s_waitcnt vmcnt(0)" ::: "memory");
    __syncthreads();
    if (threadIdx.x == 0) {
        unsigned* bar = b.bar;
        __builtin_amdgcn_s_waitcnt(0);
        unsigned nloc = b.st[0], nx = b.st[1];
        if (nloc == 0u) { xcd_barrier_complete(bar, b.x, nloc, nx); b.st[0] = nloc; b.st[1] = nx; }
        const unsigned old = xb_add(&bar[XB_XSUB(b.x)], 1u);
        const unsigned gen = old / nloc;
        if (old + 1u == (gen + 1u) * nloc) {
            __builtin_amdgcn_fence(__ATOMIC_RELEASE, "agent");
            asm volatile("s_waitcnt vmcnt(0)" ::: "memory");
            const unsigned og = xb_add(&bar[XB_TOP], 1u);
            const unsigned tg = og / nx;
            if (og + 1u == (tg + 1u) * nx) xb_add(&bar[XB_TOPGEN], 1u);
            else XB_SPIN(xb_ld(&bar[XB_TOPGEN]) == tg, bar);
            __builtin_amdgcn_fence(__ATOMIC_ACQUIRE, "agent");
            xb_add(&bar[XB_XGEN(b.x)], 1u);
            asm volatile("s_waitcnt vmcnt(0)" ::: "memory");
        } else {
            XB_SPIN(xb_ld(&bar[XB_XGEN(b.x)]) == gen, bar);
            __builtin_amdgcn_fence(__ATOMIC_ACQUIRE, "agent");
            asm volatile("s_waitcnt vmcnt(0)" ::: "memory");
        }
    }
    __syncthreads();
}

__global__ void k_mod(const float* __restrict__ c_ctx, const float* __restrict__ c, const float* __restrict__ ada_w, const float* __restrict__ ada_b, float* __restrict__ MOD) {
    const int gid = blockIdx.x * blockDim.x + threadIdx.x;
    if (gid >= NLAYER * 6 * DM) return;
    const int l = gid / (6 * DM), j = gid % (6 * DM);
    float a0 = 0.f, a1 = 0.f, a2 = 0.f;
    const float* w = ada_w + (size_t)l * DM * 6 * DM + j;
    for (int k = 0; k < DM; ++k) {
        const float wv = w[(size_t)k * 6 * DM];
        a0 += silu_f(c_ctx[k]) * wv; a1 += silu_f(c[k]) * wv; a2 += silu_f(c[DM + k]) * wv;
    }
    const float b = ada_b[l * 6 * DM + j];
    MOD[(l * 3 + 0) * 6 * DM + j] = a0 + b; MOD[(l * 3 + 1) * 6 * DM + j] = a1 + b; MOD[(l * 3 + 2) * 6 * DM + j] = a2 + b;
}

__global__ void k_wT(const float* __restrict__ W, bf16* __restrict__ WT, int K, int N) {
    __shared__ float t[32][33];
    const int n0 = blockIdx.x * 32, k0 = blockIdx.y * 32, tx = threadIdx.x & 31, ty = threadIdx.x >> 5;
    for (int i = ty; i < 32; i += 8) t[i][tx] = W[(size_t)(k0 + i) * N + n0 + tx];
    __syncthreads();
    for (int i = ty; i < 32; i += 8) WT[(size_t)(n0 + i) * K + k0 + tx] = (bf16)f2bf(t[tx][i]);
}

__global__ void k_norm_mod(const float* __restrict__ xp, const float* __restrict__ xs, const float* __restrict__ g, const float* __restrict__ MODl, int sh_idx, int sc_idx, bf16* __restrict__ H) {
    const int row = (blockIdx.x * blockDim.x + threadIdx.x) >> 6, lane = threadIdx.x & 63;
    if (row >= MROWS) return;
    const float* x = row < M_CTX ? xp + (size_t)row * DM : xs + (size_t)(row - M_CTX) * DM;
    const float* md = MODl + (size_t)cond_of_row(row) * 6 * DM;
    float v[16]; float ss = 0.f;
#pragma unroll
    for (int i = 0; i < 16; ++i) { v[i] = x[lane + 64 * i]; ss += v[i] * v[i]; }
    const float rstd = rsqrtf(wave_sum(ss) * (1.f / DM) + EPS);
#pragma unroll
    for (int i = 0; i < 16; ++i) { const int cidx = lane + 64 * i;
        H[(size_t)row * DM + cidx] = (bf16)f2bf(v[i] * rstd * g[cidx] * (1.f + md[sc_idx * DM + cidx]) + md[sh_idx * DM + cidx]); }
}

struct EpiF32 { float* C; int ldc; int pad;
    __device__ __forceinline__ void operator()(int row, int col, float v0, float v1) const { C[(size_t)row * ldc + col] = v0; C[(size_t)row * ldc + col + 16] = v1; } };
struct EpiBf { bf16* C; int ldc; int pad;
    __device__ __forceinline__ void operator()(int row, int col, float v0, float v1) const { C[(size_t)row * ldc + col] = (bf16)f2bf(v0); C[(size_t)row * ldc + col + 16] = (bf16)f2bf(v1); } };
struct EpiIn { bf16* P; float* out; int layer; int pad;
    __device__ __forceinline__ void operator()(int row, int col, float v0, float v1) const {
        const int seg = col >> 9;
        const bool lat = row >= M_CTX;
        if (lat && seg <= 1) {
            const int t = (row - M_CTX) & (T_LAT - 1), hd = col & 63;
            const float pos = (hd < 32) ? (float)(t >> 6) : (float)(t & 63);
            const int i = hd & 15;
            const float inv = exp2f(-(float)i * (13.287712379549449f / 16.f));
            const float ang = pos * inv; const float cs = cosf(ang), sn = sinf(ang);
            const float o0 = v0 * cs - v1 * sn, o1 = v0 * sn + v1 * cs; v0 = o0; v1 = o1;
        }
        if (seg == 0 || seg == 4) { v0 *= 0.125f; v1 *= 0.125f; }
        if (!lat && seg >= 5) {
            const int b = row >> 8, t = row & 255, cc = col & 511;
            float* o = out + (seg == 5 ? O_NK : O_NV) + ((size_t)((b * 2 + layer) * 256 + t)) * 512 + cc;
            o[0] = v0; o[16] = v1;
        }
        P[(size_t)row * NIN + col] = (bf16)f2bf(v0); P[(size_t)row * NIN + col + 16] = (bf16)f2bf(v1);
    } };

template <class Epi>
__global__ void __launch_bounds__(256) k_gemm(const bf16* __restrict__ A, const bf16* __restrict__ WT, int K, Epi E) {
    const int wave = threadIdx.x >> 6, lane = threadIdx.x & 63, fr = lane & 15, fq = lane >> 4;
    const int row0 = blockIdx.y * 64 + (wave >> 1) * 32, col0 = blockIdx.x * 64 + (wave & 1) * 32;
    f32x4 acc[2][2];
#pragma unroll
    for (int i = 0; i < 2; ++i)
#pragma unroll
        for (int j = 0; j < 2; ++j) acc[i][j] = (f32x4){0.f, 0.f, 0.f, 0.f};
    const bf16* a0 = A + (size_t)(row0 + fr) * K + fq * 8; const bf16* a1 = a0 + (size_t)16 * K;
    const bf16* b0 = WT + (size_t)(col0 + fr) * K + fq * 8; const bf16* b1 = b0 + (size_t)16 * K;
    for (int k = 0; k < K; k += 32) {
        const bf16x8 fa0 = *(const bf16x8*)(a0 + k), fa1 = *(const bf16x8*)(a1 + k), fb0 = *(const bf16x8*)(b0 + k), fb1 = *(const bf16x8*)(b1 + k);
        acc[0][0] = __builtin_amdgcn_mfma_f32_16x16x32_bf16(fa0, fb0, acc[0][0], 0, 0, 0);
        acc[0][1] = __builtin_amdgcn_mfma_f32_16x16x32_bf16(fa0, fb1, acc[0][1], 0, 0, 0);
        acc[1][0] = __builtin_amdgcn_mfma_f32_16x16x32_bf16(fa1, fb0, acc[1][0], 0, 0, 0);
        acc[1][1] = __builtin_amdgcn_mfma_f32_16x16x32_bf16(fa1, fb1, acc[1][1], 0, 0, 0);
    }
#pragma unroll
    for (int i = 0; i < 2; ++i)
#pragma unroll
        for (int r = 0; r < 4; ++r) E(row0 + 16 * i + 4 * fq + r, col0 + fr, acc[i][0][r], acc[i][1][r]);
}

__global__ void __launch_bounds__(256) k_ret_naive(const bf16* __restrict__ P, const float* __restrict__ dec_f, const float* __restrict__ dec_b,
                                                    const float* __restrict__ s0f, const float* __restrict__ s0b, int layer, bf16* __restrict__ MIX) {
    __shared__ float qs[4][64];
    const int wv = threadIdx.x >> 6, lane = threadIdx.x & 63;
    const int w = blockIdx.x * 4 + wv; const int row = w >> 3, h = w & 7;
    const bool lat = row >= M_CTX;
    const int T = lat ? T_LAT : T_CTX, t = lat ? ((row - M_CTX) & (T_LAT - 1)) : (row & (T_CTX - 1)), base = row - t;
    const float lgf2 = log_sigmoid_f(dec_f[h]) * LOG2E, lgb2 = log_sigmoid_f(dec_b[h]) * LOG2E;
    qs[wv][lane] = bf2f(P[(size_t)row * NIN + C_RQ + h * 64 + lane]);
    __syncthreads();
    float o = 0.f;
    for (int jb = 0; jb < T; jb += 64) {
        const int j = jb + lane;
        const bf16* kr = P + (size_t)(base + j) * NIN + C_RK + h * 64;
        float s = 0.f;
#pragma unroll
        for (int d8 = 0; d8 < 8; ++d8) { const bf16x8 kv = *(const bf16x8*)(kr + d8 * 8);
#pragma unroll
            for (int x = 0; x < 8; ++x) s += qs[wv][d8 * 8 + x] * bf2f((bf16)kv[x]); }
        float wgt = 0.f;
        if (j <= t) wgt += exp2f(lgf2 * (float)(t - j));
        if (j >= t) wgt += exp2f(lgb2 * (float)(j - t));
        s *= wgt;
        const bf16* vb = P + (size_t)(base + jb) * NIN + C_RV + h * 64 + lane;
        for (int jj = 0; jj < 64; ++jj) o += __shfl(s, jj) * bf2f(vb[(size_t)jj * NIN]);
    }
    if (lat) {
        const int b = (row - M_CTX) >> 12;
        const float* Sf = s0f + ((size_t)((b * 2 + layer) * 8 + h)) * 4096; const float* Sb = s0b + ((size_t)((b * 2 + layer) * 8 + h)) * 4096;
        float cf = 0.f, cb = 0.f;
        for (int d = 0; d < 64; ++d) { cf += qs[wv][d] * Sf[d * 64 + lane]; cb += qs[wv][d] * Sb[d * 64 + lane]; }
        o += exp2f(lgf2 * (float)(t + 1)) * cf + exp2f(lgb2 * (float)(T - t)) * cb;
    }
    const float mu = wave_sum(o) * (1.f / 64.f); const float dv = o - mu; const float var = wave_sum(dv * dv) * (1.f / 64.f);
    const float on = dv * rsqrtf(var + EPS);
    const float g = bf2f(P[(size_t)row * NIN + C_RG + h * 64 + lane]);
    MIX[(size_t)row * DM + h * 64 + lane] = (bf16)f2bf(on * silu_f(g));
}
__global__ void k_ret_states_naive(const bf16* __restrict__ P, const float* __restrict__ dec_f, const float* __restrict__ dec_b, int layer, float* __restrict__ out) {
    const int gid = blockIdx.x * blockDim.x + threadIdx.x;
    const int e = gid & 63, d = (gid >> 6) & 63, h = (gid >> 12) & 7, b = gid >> 15;
    const float lgf2 = log_sigmoid_f(dec_f[h]) * LOG2E, lgb2 = log_sigmoid_f(dec_b[h]) * LOG2E;
    float sf = 0.f, sb = 0.f;
    for (int j = 0; j < T_CTX; ++j) {
        const bf16* pr = P + (size_t)(b * 256 + j) * NIN;
        const float kv = bf2f(pr[C_RK + h * 64 + d]) * bf2f(pr[C_RV + h * 64 + e]);
        sf += exp2f(lgf2 * (float)(T_CTX - 1 - j)) * kv; sb += exp2f(lgb2 * (float)j) * kv;
    }
    const size_t o = ((size_t)((b * 2 + layer) * 8 + h)) * 4096 + d * 64 + e;
    out[O_RF + o] = sf; out[O_RB + o] = sb;
}
__global__ void __launch_bounds__(256) k_ctxattn_naive(const bf16* __restrict__ P, bf16* __restrict__ MIX) {
    __shared__ float qs[4][64];
    const int wv = threadIdx.x >> 6, lane = threadIdx.x & 63;
    const int w = blockIdx.x * 4 + wv; const int row = w >> 3, h = w & 7;
    const int t = row & 255, base = row - t;
    qs[wv][lane] = bf2f(P[(size_t)row * NIN + C_NQ + h * 64 + lane]);
    __syncthreads();
    float s[4]; float mx = -1e30f;
#pragma unroll
    for (int i = 0; i < 4; ++i) { const bf16* kr = P + (size_t)(base + i * 64 + lane) * NIN + C_NK + h * 64; float a = 0.f;
        for (int d = 0; d < 64; ++d) a += qs[wv][d] * bf2f(kr[d]);
        s[i] = a; mx = fmaxf(mx, a); }
    mx = wave_max(mx);
    float sum = 0.f;
#pragma unroll
    for (int i = 0; i < 4; ++i) { s[i] = __expf(s[i] - mx); sum += s[i]; }
    sum = wave_sum(sum);
    float o = 0.f;
#pragma unroll
    for (int i = 0; i < 4; ++i) for (int jj = 0; jj < 64; ++jj) o += __shfl(s[i], jj) * bf2f(P[(size_t)(base + i * 64 + jj) * NIN + C_NV + h * 64 + lane]);
    MIX[(size_t)row * DM + 512 + h * 64 + lane] = (bf16)f2bf(o / sum);
}
__global__ void __launch_bounds__(256) k_na_naive(const bf16* __restrict__ P, const float* __restrict__ ck, const float* __restrict__ cv, const float* __restrict__ rpb, int layer, bf16* __restrict__ MIX) {
    __shared__ float qs[4][64];
    const int wv = threadIdx.x >> 6, lane = threadIdx.x & 63;
    const int w = blockIdx.x * 4 + wv; const int row = M_CTX + (w >> 3), h = w & 7;
    const int b = (row - M_CTX) >> 12, t = (row - M_CTX) & 4095, r = t >> 6, qc = t & 63, base = row - t;
    const int rs = min(max(r - 4, 0), 56), cs = min(max(qc - 8, 0), 48);
    qs[wv][lane] = bf2f(P[(size_t)row * NIN + C_NQ + h * 64 + lane]);
    __syncthreads();
    float s[10]; float mx = -1e30f;
#pragma unroll
    for (int i = 0; i < 2; ++i) { const int kl = lane + 64 * i, kr = rs + (kl >> 4), kc = cs + (kl & 15);
        const bf16* kp = P + (size_t)(base + kr * 64 + kc) * NIN + C_NK + h * 64; float a = 0.f;
        for (int d = 0; d < 64; ++d) a += qs[wv][d] * bf2f(kp[d]);
        a += rpb[((size_t)(layer * 8 + h) * 15 + (kr - r + 7)) * 31 + (kc - qc + 15)];
        s[i] = a; mx = fmaxf(mx, a); }
#pragma unroll
    for (int i = 0; i < 8; ++i) { const int n = lane + 64 * i; const float* kp = ck + ((size_t)((b * 2 + layer) * PAST + n) * 8 + h) * 64; float a = 0.f;
        for (int d = 0; d < 64; ++d) a += qs[wv][d] * kp[d];
        s[2 + i] = a; mx = fmaxf(mx, a); }
    mx = wave_max(mx);
    float sum = 0.f;
#pragma unroll
    for (int i = 0; i < 10; ++i) { s[i] = __expf(s[i] - mx); sum += s[i]; }
    sum = wave_sum(sum);
    float o = 0.f;
#pragma unroll
    for (int i = 0; i < 2; ++i) for (int jj = 0; jj < 64; ++jj) { const int kl = jj + 64 * i, kr = rs + (kl >> 4), kc = cs + (kl & 15);
        o += __shfl(s[i], jj) * bf2f(P[(size_t)(base + kr * 64 + kc) * NIN + C_NV + h * 64 + lane]); }
#pragma unroll
    for (int i = 0; i < 8; ++i) for (int jj = 0; jj < 64; ++jj) { const int n = jj + 64 * i;
        o += __shfl(s[2 + i], jj) * cv[((size_t)((b * 2 + layer) * PAST + n) * 8 + h) * 64 + lane]; }
    MIX[(size_t)row * DM + 512 + h * 64 + lane] = (bf16)f2bf(o / sum);
}
__global__ void k_post_norm(const float* __restrict__ Y, const float* xp, const float* xs, float* X, const float* __restrict__ gpost, const float* __restrict__ MODl, int ga_idx,
                            const float* __restrict__ gnext, const float* __restrict__ MODn, int sh_idx, int sc_idx, bf16* __restrict__ H) {
    const int row = (blockIdx.x * blockDim.x + threadIdx.x) >> 6, lane = threadIdx.x & 63;
    if (row >= MROWS) return;
    const float* xo = row < M_CTX ? xp + (size_t)row * DM : xs + (size_t)(row - M_CTX) * DM;
    const int ci = cond_of_row(row);
    const float* md = MODl + (size_t)ci * 6 * DM;
    float y[16], x[16]; float ss = 0.f;
#pragma unroll
    for (int i = 0; i < 16; ++i) { y[i] = Y[(size_t)row * DM + lane + 64 * i]; ss += y[i] * y[i]; }
    const float rstd = rsqrtf(wave_sum(ss) * (1.f / DM) + EPS);
    float s2 = 0.f;
#pragma unroll
    for (int i = 0; i < 16; ++i) { const int cidx = lane + 64 * i; x[i] = xo[cidx] + md[ga_idx * DM + cidx] * (y[i] * rstd * gpost[cidx]); s2 += x[i] * x[i]; }
#pragma unroll
    for (int i = 0; i < 16; ++i) X[(size_t)row * DM + lane + 64 * i] = x[i];
    if (gnext) {
        const float* mn = MODn + (size_t)ci * 6 * DM;
        const float r2 = rsqrtf(wave_sum(s2) * (1.f / DM) + EPS);
#pragma unroll
        for (int i = 0; i < 16; ++i) { const int cidx = lane + 64 * i;
            H[(size_t)row * DM + cidx] = (bf16)f2bf(x[i] * r2 * gnext[cidx] * (1.f + mn[sc_idx * DM + cidx]) + mn[sh_idx * DM + cidx]); }
    }
}
__global__ void k_convgate(const bf16* __restrict__ U, const float* __restrict__ cw, const float* __restrict__ cb, bf16* __restrict__ ACT) {
    const size_t gid = (size_t)blockIdx.x * blockDim.x + threadIdx.x;
    if (gid >= (size_t)MROWS * NFF) return;
    const int row = (int)(gid / NFF), j = (int)(gid % NFF);
    const bool lat = row >= M_CTX; const int T = lat ? T_LAT : T_CTX, t = lat ? ((row - M_CTX) & (T_LAT - 1)) : (row & (T_CTX - 1));
    float a = cb[j], g = cb[NFF + j];
    const bf16* u = U + (size_t)row * NUP;
    if (t > 0) { a += cw[j] * bf2f(u[j - NUP]); g += cw[NFF + j] * bf2f(u[NFF + j - NUP]); }
    a += cw[NUP + j] * bf2f(u[j]); g += cw[NUP + NFF + j] * bf2f(u[NFF + j]);
    if (t < T - 1) { a += cw[2 * NUP + j] * bf2f(u[j + NUP]); g += cw[2 * NUP + NFF + j] * bf2f(u[NFF + j + NUP]); }
    ACT[(size_t)row * NFF + j] = (bf16)f2bf(silu_f(g) * a);
}

constexpr int NWAVES = 8, NTHREADS = 512;
constexpr int RING_BYTES = 131072, LDSCTL_OFF = RING_BYTES, MISC_OFF = LDSCTL_OFF + 320, LDS_BYTES = 147456;
constexpr int CW_BAR = 4096;

struct Args { const float* in[23]; float* out; unsigned char* ws; int ph_lo, ph_hi; };
typedef const __attribute__((address_space(4))) Args* KArgs;
enum { I_XP = 0, I_XS = 1, I_C = 2, I_CK = 3, I_CV = 4, I_SF = 5, I_SB = 6, I_CCTX = 7, I_ADAW = 8, I_ADAB = 9, I_GPM = 10, I_GQM = 11, I_GPF = 12, I_GQF = 13,
       I_WIN = 14, I_DECF = 15, I_DECB = 16, I_RPB = 17, I_WOUT = 18, I_WUP = 19, I_CW = 20, I_CB = 21, I_WDOWN = 22 };
struct Ctx {
    LAS unsigned char* lds;
    int tid, lane, wave, G, vcu, bx;
    KArgs ap;
};
#define WSP(T, off) ((T*)(C.ap->ws + (off)))
#define INP(i) (C.ap->in[i])
__device__ __forceinline__ unsigned pk2(float lo, float hi) { return pg8::cvt_pk_bf16(lo, hi); }

struct EpiInF {
    static constexpr bool PERM = false, AFTER_DRAIN = false;
    bf16* P; float* out; int layer;
    __device__ __forceinline__ void operator()(const f32x4 (&acc)[2][2][4][2], const pg8::Unit& u, int wr, int wc, int fr, int fq) const {
        const int seg = u.pn >> 1; const bool lat = u.pm >= 16;
        const int row0 = u.pm * 256 + wr * 64 + fr;
        const int col0 = u.pn * 256 + wc * 32 + 4 * fq;
        const bool do_rope = lat && seg <= 1;
        float inv[4];
        { int fqq = fq; asm volatile("" : "+v"(fqq));
#pragma unroll
          for (int x = 0; x < 4; ++x) inv[x] = exp2f(-(float)(4 * fqq + x) * (13.287712379549449f / 16.f)); }
        const float qs = (seg == 0 || seg == 4) ? 0.125f : 1.f;
#pragma unroll
        for (int ai = 0; ai < 2; ++ai)
#pragma unroll
            for (int m = 0; m < 4; ++m) {
                const int row = row0 + ai * 128 + m * 16;
                float cs[4], sn[4];
                if (do_rope) {
                    const int t = (row - M_CTX) & (T_LAT - 1);
                    const float pos = (wc & 1) ? (float)(t & 63) : (float)(t >> 6);
#pragma unroll
                    for (int x = 0; x < 4; ++x) { const float ang = pos * inv[x]; cs[x] = __cosf(ang); sn[x] = __sinf(ang); }
                }
#pragma unroll
                for (int bj = 0; bj < 2; ++bj) {
                    f32x4 v0 = acc[ai][bj][m][0], v1 = acc[ai][bj][m][1];
                    if (do_rope) {
#pragma unroll
                        for (int x = 0; x < 4; ++x) { const float a = v0[x], b = v1[x]; v0[x] = a * cs[x] - b * sn[x]; v1[x] = a * sn[x] + b * cs[x]; }
                    }
                    v0 = v0 * qs; v1 = v1 * qs;
                    const int col = col0 + bj * 128;
                    if (!lat && seg >= 5) {
                        float* o = out + (seg == 5 ? O_NK : O_NV) + ((size_t)((u.pm * 2 + layer) * 256 + (row & 255))) * 512 + (col & 511);
                        *(f32x4*)o = v0; *(f32x4*)(o + 16) = v1;
                    }
                    bf16* p = P + (size_t)row * NIN + col;
                    uint2 w0, w1; w0.x = pk2(v0[0], v0[1]); w0.y = pk2(v0[2], v0[3]); w1.x = pk2(v1[0], v1[1]); w1.y = pk2(v1[2], v1[3]);
                    *(uint2*)p = w0; *(uint2*)(p + 16) = w1;
                }
            }
    }
};
struct EpiF32F {
    static constexpr bool PERM = false, AFTER_DRAIN = false;
    float* C; int ldc;
    __device__ __forceinline__ void operator()(const f32x4 (&acc)[2][2][4][2], const pg8::Unit& u, int wr, int wc, int fr, int fq) const {
        const int row0 = u.pm * 256 + wr * 64 + fr, col0 = u.pn * 256 + wc * 32 + 4 * fq;
#pragma unroll
        for (int ai = 0; ai < 2; ++ai)
#pragma unroll
            for (int m = 0; m < 4; ++m) { float* rowp = C + (size_t)(row0 + ai * 128 + m * 16) * ldc + col0;
#pragma unroll
                for (int bj = 0; bj < 2; ++bj)
#pragma unroll
                    for (int n = 0; n < 2; ++n) *(f32x4*)(rowp + bj * 128 + n * 16) = acc[ai][bj][m][n]; }
    }
};
struct EpiBfF {
    static constexpr bool PERM = true, AFTER_DRAIN = false;
    bf16* O; int ldc;
    __device__ __forceinline__ void operator()(const f32x4 (&acc)[2][2][4][2], const pg8::Unit& u, int wr, int wc, int fr, int fq) const {
        const int row0 = u.pm * 256 + wr * 64 + fr, col0 = u.pn * 256 + wc * 32 + 8 * fq;
#pragma unroll
        for (int ai = 0; ai < 2; ++ai)
#pragma unroll
            for (int m = 0; m < 4; ++m) { bf16* rowp = O + (size_t)(row0 + ai * 128 + m * 16) * ldc + col0;
#pragma unroll
                for (int bj = 0; bj < 2; ++bj) { const f32x4 v0 = acc[ai][bj][m][0], v1 = acc[ai][bj][m][1];
                    u32x4 w; w.x = pk2(v0[0], v0[1]); w.y = pk2(v0[2], v0[3]); w.z = pk2(v1[0], v1[1]); w.w = pk2(v1[2], v1[3]);
                    *(u32x4*)(rowp + bj * 128) = w; } }
    }
};

#ifndef MOD_DETERMINISTIC
#define MOD_DETERMINISTIC 0
#endif
constexpr int MOD_ITEMS = NLAYER * 24 * 8;
constexpr int TI_IN = (DM / 64) * (NIN / 32), TI_OUT = (DM / 64) * (DM / 32), TI_UP = (DM / 64) * (NUP / 32), TI_DOWN = (NFF / 64) * (DM / 32), TI_LAYER = TI_IN + TI_OUT + TI_UP + TI_DOWN;
__device__ __forceinline__ void mod_item(const Ctx& C, int it) {
    const int l = it / 192, rem = it % 192, cb = rem >> 3, kc = rem & 7;
    if (MOD_DETERMINISTIC && kc != 0) return;
    const int j0 = cb * 256 + C.lane * 4, k0 = kc * 128;
    f32x4 a0 = {0.f, 0.f, 0.f, 0.f}, a1 = a0, a2 = a0;
    const float* w = INP(I_ADAW) + ((size_t)l * DM + k0) * (6 * DM) + j0; const float* c_ctx = INP(I_CCTX); const float* cc = INP(I_C);
#pragma unroll 8
    for (int k = 0; k < (MOD_DETERMINISTIC ? 1024 : 128); ++k) {
        const f32x4 wv = *(const f32x4*)(w + (size_t)k * (6 * DM));
        const float s0 = silu_f(c_ctx[k0 + k]), s1 = silu_f(cc[k0 + k]), s2 = silu_f(cc[DM + k0 + k]);
        a0 += wv * s0; a1 += wv * s1; a2 += wv * s2;
    }
    if (kc == 0) { const f32x4 b = *(const f32x4*)(INP(I_ADAB) + l * 6 * DM + j0); a0 += b; a1 += b; a2 += b; }
    float* m0 = WSP(float, WS_MOD) + (size_t)(l * 3) * 6 * DM + j0;
    if (MOD_DETERMINISTIC) { *(f32x4*)m0 = a0; *(f32x4*)(m0 + 6 * DM) = a1; *(f32x4*)(m0 + 12 * DM) = a2; return; }
#pragma unroll
    for (int x = 0; x < 4; ++x) {
        __hip_atomic_fetch_add(m0 + x, a0[x], __ATOMIC_RELAXED, __HIP_MEMORY_SCOPE_AGENT);
        __hip_atomic_fetch_add(m0 + 6 * DM + x, a1[x], __ATOMIC_RELAXED, __HIP_MEMORY_SCOPE_AGENT);
        __hip_atomic_fetch_add(m0 + 12 * DM + x, a2[x], __ATOMIC_RELAXED, __HIP_MEMORY_SCOPE_AGENT);
    }
}
__device__ __forceinline__ void transpose_item(const float* W, int K, int N, bf16* WT, LAS float* scr, int item, int lane) {
    const int nblk = N / 32, kb = item / nblk, nb = item % nblk, k0 = 64 * kb, n0 = 32 * nb;
#pragma unroll 8
    for (int i = 0; i < 32; ++i) { const int kk = 2 * i + (lane >> 5); scr[kk * 33 + (lane & 31)] = W[(size_t)(k0 + kk) * N + n0 + (lane & 31)]; }
    asm volatile("s_waitcnt lgkmcnt(0)" ::: "memory");
    const int c = lane & 7;
#pragma unroll
    for (int j = 0; j < 4; ++j) { const int n = (lane >> 3) + 8 * j; const LAS float* s = scr + (8 * c) * 33 + n;
        u32x4 o; o.x = pk2(s[0 * 33], s[1 * 33]); o.y = pk2(s[2 * 33], s[3 * 33]); o.z = pk2(s[4 * 33], s[5 * 33]); o.w = pk2(s[6 * 33], s[7 * 33]);
        *(u32x4*)(WT + (size_t)(n0 + n) * K + k0 + 8 * c) = o; }
    asm volatile("s_waitcnt lgkmcnt(0)" ::: "memory");
}
__device__ __forceinline__ void ph_prologue(const Ctx& C) {
    LAS float* scr = (LAS float*)(C.lds + C.wave * 16384);
    const int gw = C.vcu * NWAVES + C.wave, NGW = C.G * NWAVES;
    for (int it = gw; it < MOD_ITEMS + NLAYER * TI_LAYER; it += NGW) {
        if (it < MOD_ITEMS) { mod_item(C, it); continue; }
        int r = it - MOD_ITEMS; const int l = r / TI_LAYER; r -= l * TI_LAYER;
        unsigned char* wl = C.ap->ws + WS_W + (size_t)l * W_LAYER_BYTES;
        if (r < TI_IN) { transpose_item(INP(I_WIN) + (size_t)l * DM * NIN, DM, NIN, (bf16*)(wl + W_IN_OFF), scr, r, C.lane); continue; } r -= TI_IN;
        if (r < TI_OUT) { transpose_item(INP(I_WOUT) + (size_t)l * DM * DM, DM, DM, (bf16*)(wl + W_OUT_OFF), scr, r, C.lane); continue; } r -= TI_OUT;
        if (r < TI_UP) { transpose_item(INP(I_WUP) + (size_t)l * DM * NUP, DM, NUP, (bf16*)(wl + W_UP_OFF), scr, r, C.lane); continue; } r -= TI_UP;
        transpose_item(INP(I_WDOWN) + (size_t)l * NFF * DM, NFF, DM, (bf16*)(wl + W_DOWN_OFF), scr, r, C.lane);
    }
}

__device__ __forceinline__ void store_h_row(bf16* hrow, int lane, const f32x4 (&x)[4], float rstd, const float* g, const float* sc, const float* sh) {
#pragma unroll
    for (int j = 0; j < 4; ++j) { const int c0 = 4 * lane + 256 * j;
        const f32x4 gv = *(const f32x4*)(g + c0), scv = *(const f32x4*)(sc + c0), shv = *(const f32x4*)(sh + c0);
        const f32x4 h = x[j] * rstd * gv * (scv + 1.f) + shv;
        uint2 w; w.x = pk2(h[0], h[1]); w.y = pk2(h[2], h[3]); *(uint2*)(hrow + c0) = w; }
}
__device__ __forceinline__ void ph_norm_in(const Ctx& C) {
    const int gw = C.vcu * NWAVES + C.wave, NGW = C.G * NWAVES;
    const float* x_prompt = INP(I_XP); const float* x_sample = INP(I_XS); const float* MOD = WSP(float, WS_MOD); const float* gpm = INP(I_GPM); bf16* H = WSP(bf16, WS_HA);
    for (int row = gw; row < MROWS; row += NGW) {
        const float* x = row < M_CTX ? x_prompt + (size_t)row * DM : x_sample + (size_t)(row - M_CTX) * DM;
        const float* md = MOD + (size_t)cond_of_row(row) * 6 * DM;
        f32x4 v[4]; float ss = 0.f;
#pragma unroll
        for (int j = 0; j < 4; ++j) { v[j] = *(const f32x4*)(x + 4 * C.lane + 256 * j); ss += (v[j][0] * v[j][0] + v[j][1] * v[j][1]) + (v[j][2] * v[j][2] + v[j][3] * v[j][3]); }
        const float rstd = rsqrtf(wave_sum(ss) * (1.f / DM) + EPS);
        store_h_row(H + (size_t)row * DM, C.lane, v, rstd, gpm, md + 1 * DM, md + 0 * DM);
    }
}
__device__ __forceinline__ void ph_post_norm(const Ctx& C, int l, int which) {
    const int gw = C.vcu * NWAVES + C.wave, NGW = C.G * NWAVES;
    const float* gpost = (which == 0 ? INP(I_GQM) : INP(I_GQF)) + l * DM;
    const bool has_next = (which == 0) || (l + 1 < NLAYER);
    const float* gnext = which == 0 ? INP(I_GPF) + l * DM : INP(I_GPM) + (l + 1) * DM;
    const int ga_idx = which == 0 ? 2 : 5, sh_idx = which == 0 ? 3 : 0, sc_idx = which == 0 ? 4 : 1, ln = which == 0 ? l : l + 1;
    float* X = C.ap->out; const float* x_prompt = INP(I_XP); const float* x_sample = INP(I_XS); const float* MOD = WSP(float, WS_MOD); const float* Y = WSP(float, WS_BIG); bf16* H = WSP(bf16, WS_HA);
    for (int row = gw; row < MROWS; row += NGW) {
        const float* xo = (which == 0 && l == 0) ? (row < M_CTX ? x_prompt + (size_t)row * DM : x_sample + (size_t)(row - M_CTX) * DM) : X + (size_t)row * DM;
        const int ci = cond_of_row(row);
        const float* md = MOD + (size_t)(l * 3 + ci) * 6 * DM;
        f32x4 y[4], x[4]; float ss = 0.f;
#pragma unroll
        for (int j = 0; j < 4; ++j) { y[j] = *(const f32x4*)(Y + (size_t)row * DM + 4 * C.lane + 256 * j); ss += (y[j][0] * y[j][0] + y[j][1] * y[j][1]) + (y[j][2] * y[j][2] + y[j][3] * y[j][3]); }
        const float rstd = rsqrtf(wave_sum(ss) * (1.f / DM) + EPS);
        float s2 = 0.f;
#pragma unroll
        for (int j = 0; j < 4; ++j) { const int c0 = 4 * C.lane + 256 * j;
            const f32x4 xv = *(const f32x4*)(xo + c0), gav = *(const f32x4*)(md + ga_idx * DM + c0), gp = *(const f32x4*)(gpost + c0);
            x[j] = xv + gav * (y[j] * rstd * gp);
            s2 += (x[j][0] * x[j][0] + x[j][1] * x[j][1]) + (x[j][2] * x[j][2] + x[j][3] * x[j][3]); }
#pragma unroll
        for (int j = 0; j < 4; ++j) *(f32x4*)(X + (size_t)row * DM + 4 * C.lane + 256 * j) = x[j];
        if (has_next) {
            const float* mn = MOD + (size_t)(ln * 3 + ci) * 6 * DM;
            const float r2 = rsqrtf(wave_sum(s2) * (1.f / DM) + EPS);
            store_h_row(H + (size_t)row * DM, C.lane, x, r2, gnext, mn + sc_idx * DM, mn + sh_idx * DM);
        }
    }
}
__device__ __forceinline__ void bf8_to_f(const bf16x8 v, float (&f)[8]) {
#pragma unroll
    for (int x = 0; x < 8; ++x) f[x] = bf2f((bf16)v[x]);
}
__device__ __forceinline__ void ph_convgate(const Ctx& C, int l) {
    const float* cw = INP(I_CW) + (size_t)l * 3 * NUP; const float* cb = INP(I_CB) + (size_t)l * NUP; const bf16* U = WSP(bf16, WS_BIG); bf16* ACT = WSP(bf16, WS_HA);
    constexpr int NCH = NFF / 8, NRUN = MROWS / 16;
    for (int it = C.vcu * NTHREADS + C.tid; it < NCH * NRUN; it += C.G * NTHREADS) {
        const int run = it / NCH, ch = it % NCH, j0 = ch * 8, r0 = run * 16;
        const int T = r0 < M_CTX ? T_CTX : T_LAT, t0 = r0 < M_CTX ? (r0 & (T_CTX - 1)) : ((r0 - M_CTX) & (T_LAT - 1));
        float wa[3][8], wg[3][8], ba[8], bg[8];
#pragma unroll
        for (int i = 0; i < 3; ++i)
#pragma unroll
            for (int x = 0; x < 8; ++x) { wa[i][x] = cw[i * NUP + j0 + x]; wg[i][x] = cw[i * NUP + NFF + j0 + x]; }
#pragma unroll
        for (int x = 0; x < 8; ++x) { ba[x] = cb[j0 + x]; bg[x] = cb[NFF + j0 + x]; }
        const bf16* u = U + (size_t)r0 * NUP + j0;
        float pa[8], pg[8], ca[8], cg[8], na[8], ng[8];
        if (t0 > 0) { bf8_to_f(*(const bf16x8*)(u - NUP), pa); bf8_to_f(*(const bf16x8*)(u - NUP + NFF), pg); }
        else {
#pragma unroll
            for (int x = 0; x < 8; ++x) { pa[x] = 0.f; pg[x] = 0.f; } }
        bf8_to_f(*(const bf16x8*)(u), ca); bf8_to_f(*(const bf16x8*)(u + NFF), cg);
#pragma unroll 4
        for (int r = 0; r < 16; ++r) {
            if (t0 + r + 1 < T) { bf8_to_f(*(const bf16x8*)(u + (size_t)(r + 1) * NUP), na); bf8_to_f(*(const bf16x8*)(u + (size_t)(r + 1) * NUP + NFF), ng); }
            else {
#pragma unroll
                for (int x = 0; x < 8; ++x) { na[x] = 0.f; ng[x] = 0.f; } }
            float o[8];
#pragma unroll
            for (int x = 0; x < 8; ++x) {
                const float a = ba[x] + wa[0][x] * pa[x] + wa[1][x] * ca[x] + wa[2][x] * na[x];
                const float g = bg[x] + wg[0][x] * pg[x] + wg[1][x] * cg[x] + wg[2][x] * ng[x];
                o[x] = silu_f(g) * a; pa[x] = ca[x]; pg[x] = cg[x]; ca[x] = na[x]; cg[x] = ng[x];
            }
            u32x4 w; w.x = pk2(o[0], o[1]); w.y = pk2(o[2], o[3]); w.z = pk2(o[4], o[5]); w.w = pk2(o[6], o[7]);
            *(u32x4*)(ACT + (size_t)(r0 + r) * NFF + j0) = w;
        }
    }
}
constexpr size_t HA_VTR = 0, HA_VTN = 12 * MiB, HA_UST = 24 * MiB, HA_SST = 48 * MiB;
constexpr size_t VT_LAT_OFF = (size_t)NB_CTX * 512 * T_CTX;
constexpr size_t WS_CKB = 250 * MiB, WS_CVT = 252 * MiB, WS_NEED = 254 * MiB;
constexpr int N_UNITS = 768;
#ifndef NA_SKIP_CTX
#define NA_SKIP_CTX 0
#endif
#define MFMA16(A, B, Cc) __builtin_amdgcn_mfma_f32_16x16x32_bf16(A, B, Cc, 0, 0, 0)

__device__ __forceinline__ bf16x8 ld16(const bf16* p) { return *(const bf16x8*)p; }
__device__ __forceinline__ bf16x8 ld8x2(const bf16* p0, const bf16* p1) { const uint2 a = *(const uint2*)p0, b = *(const uint2*)p1; const u32x4 w = {a.x, a.y, b.x, b.y}; return __builtin_bit_cast(bf16x8, w); }
__device__ __forceinline__ bf16x8 pack8(const f32x4 lo, const f32x4 hi) { const u32x4 w = {pk2(lo[0], lo[1]), pk2(lo[2], lo[3]), pk2(hi[0], hi[1]), pk2(hi[2], hi[3])}; return __builtin_bit_cast(bf16x8, w); }
__device__ __forceinline__ float red4(float v) { v += __shfl_xor(v, 16); v += __shfl_xor(v, 32); return v; }
__device__ __forceinline__ float max4(float v) { v = fmaxf(v, __shfl_xor(v, 16)); v = fmaxf(v, __shfl_xor(v, 32)); return v; }
struct UnitInfo { int lat, b, h, c, T, rowbase, tpos; };
__device__ __forceinline__ UnitInfo unit_info(int uid) {
    UnitInfo u;
    if (uid < 256) { u.lat = 0; u.c = uid & 1; u.h = (uid >> 1) & 7; u.b = uid >> 4; u.T = T_CTX; u.tpos = u.c * 128; u.rowbase = u.b * 256 + u.tpos; }
    else { const int v = uid - 256; u.lat = 1; u.c = v & 31; u.h = (v >> 5) & 7; u.b = v >> 8; u.T = T_LAT; u.tpos = u.c * 128; u.rowbase = M_CTX + u.b * 4096 + u.tpos; }
    return u;
}
__device__ __forceinline__ const bf16* vt_row(const bf16* VT, int lat, int b, int h, int e) {
    return lat ? VT + VT_LAT_OFF + ((size_t)((b * 8 + h) * 64 + e)) * T_LAT : VT + ((size_t)((b * 8 + h) * 64 + e)) * T_CTX;
}

__device__ __forceinline__ void ph_cache_prep(const Ctx& C) {
    const float* ck = INP(I_CK); const float* cv = INP(I_CV); bf16* CKB = WSP(bf16, WS_CKB); bf16* CVT = WSP(bf16, WS_CVT);
    for (int id = C.vcu * NTHREADS + C.tid; id < 131072; id += C.G * NTHREADS) {
        { const int d8 = id & 7, h = (id >> 3) & 7, n = (id >> 6) & 511, bl = id >> 15;
          const float* s = ck + ((size_t)((bl * PAST + n) * 8 + h)) * 64 + d8 * 8;
          const f32x4 a = *(const f32x4*)s, b = *(const f32x4*)(s + 4);
          const u32x4 w = {pk2(a[0], a[1]), pk2(a[2], a[3]), pk2(b[0], b[1]), pk2(b[2], b[3])};
          *(u32x4*)(CKB + ((size_t)((bl * 8 + h) * PAST + n)) * 64 + d8 * 8) = w; }
        { const int e = id & 63, nch = (id >> 6) & 63, h = (id >> 12) & 7, bl = id >> 15;
          const float* s = cv + ((size_t)((bl * PAST + nch * 8) * 8 + h)) * 64 + e; float v[8];
#pragma unroll
          for (int x = 0; x < 8; ++x) v[x] = s[(size_t)x * 512];
          const u32x4 w = {pk2(v[0], v[1]), pk2(v[2], v[3]), pk2(v[4], v[5]), pk2(v[6], v[7])};
          *(u32x4*)(CVT + ((size_t)((bl * 8 + h) * 64 + e)) * PAST + nch * 8) = w; }
    }
}

__device__ __forceinline__ void r1_state_unit(const Ctx& C, int l, int uid) {
    const UnitInfo u = unit_info(uid);
    const bf16* P = WSP(bf16, WS_BIG); float* UST = WSP(float, WS_HA + HA_UST);
    const float lgf2 = log_sigmoid_f(INP(I_DECF)[l * 8 + u.h]) * LOG2E, lgb2 = log_sigmoid_f(INP(I_DECB)[l * 8 + u.h]) * LOG2E;
    LAS float* Kf = (LAS float*)C.lds; LAS float* Kb = Kf + 8192; LAS float* Vs = Kf + 16384;
    { const int jr = C.tid >> 2, seg = C.tid & 3;
      const bf16* kp = P + (size_t)(u.rowbase + jr) * NIN + C_RK + u.h * 64 + seg * 16; const bf16* vp = P + (size_t)(u.rowbase + jr) * NIN + C_RV + u.h * 64 + seg * 16;
      const float wf = exp2f(lgf2 * (float)(127 - jr)), wb = exp2f(lgb2 * (float)jr);
#pragma unroll
      for (int q = 0; q < 2; ++q) { const bf16x8 kv = ld16(kp + 8 * q), vv = ld16(vp + 8 * q); float kf[8], vf[8]; bf8_to_f(kv, kf); bf8_to_f(vv, vf);
#pragma unroll
          for (int x4 = 0; x4 < 2; ++x4) { const int o = jr * 64 + seg * 16 + q * 8 + x4 * 4;
              *(LAS f32x4*)(Kf + o) = (f32x4){kf[4 * x4] * wf, kf[4 * x4 + 1] * wf, kf[4 * x4 + 2] * wf, kf[4 * x4 + 3] * wf};
              *(LAS f32x4*)(Kb + o) = (f32x4){kf[4 * x4] * wb, kf[4 * x4 + 1] * wb, kf[4 * x4 + 2] * wb, kf[4 * x4 + 3] * wb};
              *(LAS f32x4*)(Vs + o) = (f32x4){vf[4 * x4], vf[4 * x4 + 1], vf[4 * x4 + 2], vf[4 * x4 + 3]}; } } }
    __syncthreads();
    const int ep = C.tid & 31, dq = C.tid >> 5;
    f32x4 af0 = {0.f, 0.f, 0.f, 0.f}, af1 = af0, ab0 = af0, ab1 = af0;
#pragma unroll 4
    for (int j = 0; j < 128; ++j) {
        const float v0 = Vs[j * 64 + 2 * ep], v1 = Vs[j * 64 + 2 * ep + 1];
        const f32x4 kf = *(const LAS f32x4*)(Kf + j * 64 + 4 * dq), kb = *(const LAS f32x4*)(Kb + j * 64 + 4 * dq);
        af0 += kf * v0; af1 += kf * v1; ab0 += kb * v0; ab1 += kb * v1;
    }
    float* uf = UST + ((size_t)(uid * 2 + 0)) * 4096 + (2 * ep) * 64 + 4 * dq; float* ub = uf + 4096;
    *(f32x4*)uf = af0; *(f32x4*)(uf + 64) = af1; *(f32x4*)ub = ab0; *(f32x4*)(ub + 64) = ab1;
    __syncthreads();
}
__device__ __forceinline__ void r1_transpose_item(const Ctx& C, int id) {
    const int which = id / 1536, rem = id % 1536, tb = rem >> 3, h = rem & 7, row0 = tb * 64;
    const bf16* P = WSP(bf16, WS_BIG); bf16* VT = WSP(bf16, WS_HA + (which ? HA_VTN : HA_VTR));
    const int col = (which ? C_NV : C_RV) + h * 64;
    const int lat = row0 >= M_CTX, b = lat ? (row0 - M_CTX) >> 12 : row0 >> 8, t0 = lat ? (row0 - M_CTX) & 4095 : row0 & 255;
    LAS unsigned* tile = (LAS unsigned*)(C.lds + C.wave * 16384);
#pragma unroll
    for (int i = 0; i < 4; ++i) { const int tp = i * 8 + (C.lane >> 3), e0 = (C.lane & 7) * 8;
        const bf16x8 a = ld16(P + (size_t)(row0 + 2 * tp) * NIN + col + e0), bb = ld16(P + (size_t)(row0 + 2 * tp + 1) * NIN + col + e0);
#pragma unroll
        for (int x = 0; x < 8; ++x) tile[(e0 + x) * 36 + tp] = (unsigned)(unsigned short)a[x] | ((unsigned)(unsigned short)bb[x] << 16); }
    asm volatile("s_waitcnt lgkmcnt(0)" ::: "memory");
#pragma unroll
    for (int i = 0; i < 8; ++i) { const int e = i * 8 + (C.lane >> 3), ch = C.lane & 7;
        const u32x4 v = *(const LAS u32x4*)(tile + e * 36 + ch * 4);
        *(u32x4*)((bf16*)vt_row(VT, lat, b, h, e) + t0 + 8 * ch) = v; }
    asm volatile("s_waitcnt lgkmcnt(0)" ::: "memory");
}
__device__ __forceinline__ void ph_r1(const Ctx& C, int l) {
    for (int uid = C.vcu; uid < N_UNITS; uid += C.G) r1_state_unit(C, l, uid);
    const int gw = C.vcu * NWAVES + C.wave, NGW = C.G * NWAVES;
    for (int id = gw; id < 3072; id += NGW) r1_transpose_item(C, id);
}
__device__ __forceinline__ void ph_r1b(const Ctx& C, int l) {
    const float* UST = WSP(float, WS_HA + HA_UST); bf16* SST = WSP(bf16, WS_HA + HA_SST); float* out = C.ap->out;
    const float* decf = INP(I_DECF) + l * 8; const float* decb = INP(I_DECB) + l * 8;
    for (int gid = C.vcu * NTHREADS + C.tid; gid < 131072 + 1048576; gid += C.G * NTHREADS) {
        if (gid < 131072) {
            const int elem = gid & 4095, dir = (gid >> 12) & 1, bh = gid >> 13, h = bh & 7, b = bh >> 3, e = elem >> 6, d = elem & 63;
            const float gC = exp2f(log_sigmoid_f((dir ? decb : decf)[h]) * LOG2E * 128.f);
            float s = (dir ? INP(I_SB) : INP(I_SF))[((size_t)((b * 2 + l) * 8 + h)) * 4096 + d * 64 + e];
            const int u0 = 256 + bh * 32;
            for (int i = 0; i < 32; ++i) { const int c = dir ? 31 - i : i; const size_t o = ((size_t)((u0 + c) * 2 + dir)) * 4096 + elem;
                SST[o] = (bf16)f2bf(s); s = s * gC + UST[o]; }
        } else {
            const int g2 = gid - 131072, elem = g2 & 4095, dir = (g2 >> 12) & 1, bh = g2 >> 13, h = bh & 7, b = bh >> 3, e = elem >> 6, d = elem & 63;
            const float gC = exp2f(log_sigmoid_f((dir ? decb : decf)[h]) * LOG2E * 128.f);
            const size_t o0 = ((size_t)((bh * 2 + 0) * 2 + dir)) * 4096 + elem, o1 = ((size_t)((bh * 2 + 1) * 2 + dir)) * 4096 + elem;
            const float u0 = UST[o0], u1 = UST[o1];
            float fin;
            if (dir == 0) { SST[o0] = 0; SST[o1] = (bf16)f2bf(u0); fin = u1 + gC * u0; }
            else { SST[o1] = 0; SST[o0] = (bf16)f2bf(u1); fin = u0 + gC * u1; }
            out[(dir ? O_RB : O_RF) + ((size_t)((b * 2 + l) * 8 + h)) * 4096 + d * 64 + e] = fin;
        }
    }
}
__device__ __forceinline__ void r2_ret_unit(const Ctx& C, int l, int uid, int qg) {
    const UnitInfo u = unit_info(uid);
    const bf16* P = WSP(bf16, WS_BIG); const bf16* VT = WSP(bf16, WS_HA + HA_VTR); const bf16* SST = WSP(bf16, WS_HA + HA_SST); bf16* MIX = WSP(bf16, WS_BIG + BIG_MIX_OFF);
    const float lgf2 = log_sigmoid_f(INP(I_DECF)[l * 8 + u.h]) * LOG2E, lgb2 = log_sigmoid_f(INP(I_DECB)[l * 8 + u.h]) * LOG2E;
    const int fr = C.lane & 15, g = C.lane >> 4, qi = 16 * qg + fr, qrow = u.rowbase + qi;
    const bf16* qp = P + (size_t)qrow * NIN + C_RQ + u.h * 64 + 8 * g;
    const bf16x8 q0 = ld16(qp), q1 = ld16(qp + 32);
    f32x4 s[8];
#pragma unroll
    for (int jt = 0; jt < 8; ++jt) { const bf16* kp = P + (size_t)(u.rowbase + 16 * jt + fr) * NIN + C_RK + u.h * 64 + 8 * g;
        const bf16x8 k0 = ld16(kp), k1 = ld16(kp + 32);
        f32x4 a = {0.f, 0.f, 0.f, 0.f}; a = MFMA16(k0, q0, a); a = MFMA16(k1, q1, a);
#pragma unroll
        for (int r = 0; r < 4; ++r) { const int dd = qi - (16 * jt + 4 * g + r);
            const float w = (dd >= 0 ? exp2f(lgf2 * (float)dd) : 0.f) + (dd <= 0 ? exp2f(lgb2 * (float)(-dd)) : 0.f); a[r] *= w; }
        s[jt] = a; }
    f32x4 o[4];
#pragma unroll
    for (int et = 0; et < 4; ++et) o[et] = (f32x4){0.f, 0.f, 0.f, 0.f};
#pragma unroll
    for (int kk = 0; kk < 4; ++kk) { const bf16x8 pb = pack8(s[2 * kk], s[2 * kk + 1]);
#pragma unroll
        for (int et = 0; et < 4; ++et) { const bf16* vp = vt_row(VT, u.lat, u.b, u.h, 16 * et + fr) + u.tpos + 32 * kk + 4 * g;
            o[et] = MFMA16(ld8x2(vp, vp + 16), pb, o[et]); } }
    const float qdf = exp2f(lgf2 * (float)(qi + 1)), qdb = exp2f(lgb2 * (float)(128 - qi));
#pragma unroll
    for (int et = 0; et < 4; ++et) { const bf16* sp = SST + ((size_t)(uid * 2)) * 4096 + (16 * et + fr) * 64 + 8 * g;
        f32x4 cf = {0.f, 0.f, 0.f, 0.f}, cb = cf;
        cf = MFMA16(ld16(sp), q0, cf); cf = MFMA16(ld16(sp + 32), q1, cf);
        cb = MFMA16(ld16(sp + 4096), q0, cb); cb = MFMA16(ld16(sp + 4096 + 32), q1, cb);
        o[et] += cf * qdf + cb * qdb; }
    float sum = 0.f;
#pragma unroll
    for (int et = 0; et < 4; ++et) sum += (o[et][0] + o[et][1]) + (o[et][2] + o[et][3]);
    const float mu = red4(sum) * (1.f / 64.f);
    float sq = 0.f;
#pragma unroll
    for (int et = 0; et < 4; ++et) { o[et] = o[et] - mu; sq += (o[et][0] * o[et][0] + o[et][1] * o[et][1]) + (o[et][2] * o[et][2] + o[et][3] * o[et][3]); }
    const float rstd = rsqrtf(red4(sq) * (1.f / 64.f) + EPS);
#pragma unroll
    for (int et = 0; et < 4; ++et) { const int e0 = u.h * 64 + 16 * et + 4 * g;
        const uint2 gw = *(const uint2*)(P + (size_t)qrow * NIN + C_RG + e0);
        const float g0 = __builtin_bit_cast(float, gw.x << 16), g1 = __builtin_bit_cast(float, gw.x & 0xffff0000u), g2 = __builtin_bit_cast(float, gw.y << 16), g3 = __builtin_bit_cast(float, gw.y & 0xffff0000u);
        uint2 w; w.x = pk2(o[et][0] * rstd * silu_f(g0), o[et][1] * rstd * silu_f(g1)); w.y = pk2(o[et][2] * rstd * silu_f(g2), o[et][3] * rstd * silu_f(g3));
        *(uint2*)(MIX + (size_t)qrow * DM + e0) = w; }
}
#define SOFTMAX_CHUNK(s2, NT) do { float cm_ = -1e30f; \
    _Pragma("unroll") for (int t_ = 0; t_ < NT; ++t_) cm_ = fmaxf(cm_, fmaxf(fmaxf(s2[t_][0], s2[t_][1]), fmaxf(s2[t_][2], s2[t_][3]))); \
    cm_ = max4(cm_); const float mn_ = fmaxf(m, cm_); const float al_ = exp2f(m - mn_); float cs_ = 0.f; \
    _Pragma("unroll") for (int t_ = 0; t_ < NT; ++t_) { _Pragma("unroll") for (int r_ = 0; r_ < 4; ++r_) { const float p_ = exp2f(s2[t_][r_] - mn_); s2[t_][r_] = p_; cs_ += p_; } } \
    lsum = lsum * al_ + red4(cs_); m = mn_; \
    _Pragma("unroll") for (int et_ = 0; et_ < 4; ++et_) o[et_] = o[et_] * al_; } while (0)

__device__ __forceinline__ void r2_ctx_unit(const Ctx& C, int bh, int qg) {
    const int b = bh >> 3, h = bh & 7, fr = C.lane & 15, g = C.lane >> 4, rowbase = b * 256, qrow = rowbase + 16 * qg + fr;
    const bf16* P = WSP(bf16, WS_BIG); const bf16* VT = WSP(bf16, WS_HA + HA_VTN); bf16* MIX = WSP(bf16, WS_BIG + BIG_MIX_OFF);
    const bf16* qp = P + (size_t)qrow * NIN + C_NQ + h * 64 + 8 * g;
    const bf16x8 q0 = ld16(qp), q1 = ld16(qp + 32);
    f32x4 s[16];
#pragma unroll
    for (int jt = 0; jt < 16; ++jt) { const bf16* kp = P + (size_t)(rowbase + 16 * jt + fr) * NIN + C_NK + h * 64 + 8 * g;
        f32x4 a = {0.f, 0.f, 0.f, 0.f}; a = MFMA16(ld16(kp), q0, a); a = MFMA16(ld16(kp + 32), q1, a); s[jt] = a * LOG2E; }
    float m = -1e30f, lsum = 0.f; f32x4 o[4];
#pragma unroll
    for (int et = 0; et < 4; ++et) o[et] = (f32x4){0.f, 0.f, 0.f, 0.f};
    SOFTMAX_CHUNK(s, 16);
#pragma unroll
    for (int kk = 0; kk < 8; ++kk) { const bf16x8 pb = pack8(s[2 * kk], s[2 * kk + 1]);
#pragma unroll
        for (int et = 0; et < 4; ++et) { const bf16* vp = vt_row(VT, 0, b, h, 16 * et + fr) + 32 * kk + 4 * g; o[et] = MFMA16(ld8x2(vp, vp + 16), pb, o[et]); } }
    const float il = 1.f / lsum;
#pragma unroll
    for (int et = 0; et < 4; ++et) { uint2 w; w.x = pk2(o[et][0] * il, o[et][1] * il); w.y = pk2(o[et][2] * il, o[et][3] * il);
        *(uint2*)(MIX + (size_t)qrow * DM + 512 + h * 64 + 16 * et + 4 * g) = w; }
}
__device__ __forceinline__ void r2_na_unit(const Ctx& C, int l, int id) {
    const int jb = id & 3, r = (id >> 2) & 63, h = (id >> 8) & 7, b = id >> 11, fr = C.lane & 15, g = C.lane >> 4;
    const bf16* P = WSP(bf16, WS_BIG); const bf16* VT = WSP(bf16, WS_HA + HA_VTN); bf16* MIX = WSP(bf16, WS_BIG + BIG_MIX_OFF);
    const bf16* CKB = WSP(bf16, WS_CKB); const bf16* CVT = WSP(bf16, WS_CVT); const float* rpb = INP(I_RPB) + (size_t)(l * 8 + h) * 15 * 31;
    const int rs = min(max(r - 4, 0), 56), kb = min(max(16 * jb - 8, 0), 32), qc = 16 * jb + fr, cs = min(max(qc - 8, 0), 48);
    const int latbase = M_CTX + b * 4096, qrow = latbase + r * 64 + qc;
    const bf16* qp = P + (size_t)qrow * NIN + C_NQ + h * 64 + 8 * g;
    const bf16x8 q0 = ld16(qp), q1 = ld16(qp + 32);
    float m = -1e30f, lsum = 0.f; f32x4 o[4];
#pragma unroll
    for (int et = 0; et < 4; ++et) o[et] = (f32x4){0.f, 0.f, 0.f, 0.f};
    f32x4 s[16];
#pragma unroll
    for (int tl = 0; tl < 16; ++tl) { const int kr = tl >> 1, hf = tl & 1;
        const bf16* kp = P + (size_t)(latbase + (rs + kr) * 64 + kb + 16 * hf + fr) * NIN + C_NK + h * 64 + 8 * g;
        f32x4 a = {0.f, 0.f, 0.f, 0.f}; a = MFMA16(ld16(kp), q0, a); a = MFMA16(ld16(kp + 32), q1, a);
#pragma unroll
        for (int rr = 0; rr < 4; ++rr) { const int kc = kb + 16 * hf + 4 * g + rr; const bool ok = (kc >= cs) && (kc < cs + 16);
            const float bias = rpb[ok ? ((rs + kr - r + 7) * 31 + (kc - qc + 15)) : 0];
            a[rr] = ok ? (a[rr] + bias) * LOG2E : -1e30f; }
        s[tl] = a; }
    SOFTMAX_CHUNK(s, 16);
#pragma unroll
    for (int kr = 0; kr < 8; ++kr) { const bf16x8 pb = pack8(s[2 * kr], s[2 * kr + 1]);
#pragma unroll
        for (int et = 0; et < 4; ++et) { const bf16* vp = vt_row(VT, 1, b, h, 16 * et + fr) + (rs + kr) * 64 + kb + 4 * g; o[et] = MFMA16(ld8x2(vp, vp + 16), pb, o[et]); } }
#pragma unroll 1
    for (int n0 = 0; n0 < (NA_SKIP_CTX ? 0 : PAST); n0 += 256) {
#pragma unroll
        for (int tl = 0; tl < 16; ++tl) { const bf16* kp = CKB + ((size_t)(((b * 2 + l) * 8 + h) * PAST + n0 + 16 * tl + fr)) * 64 + 8 * g;
            f32x4 a = {0.f, 0.f, 0.f, 0.f}; a = MFMA16(ld16(kp), q0, a); a = MFMA16(ld16(kp + 32), q1, a); s[tl] = a * LOG2E; }
        SOFTMAX_CHUNK(s, 16);
#pragma unroll
        for (int kk = 0; kk < 8; ++kk) { const bf16x8 pb = pack8(s[2 * kk], s[2 * kk + 1]);
#pragma unroll
            for (int et = 0; et < 4; ++et) { const bf16* vp = CVT + ((size_t)(((b * 2 + l) * 8 + h) * 64 + 16 * et + fr)) * PAST + n0 + 32 * kk + 4 * g; o[et] = MFMA16(ld8x2(vp, vp + 16), pb, o[et]); } }
    }
    const float il = 1.f / lsum;
#pragma unroll
    for (int et = 0; et < 4; ++et) { uint2 w; w.x = pk2(o[et][0] * il, o[et][1] * il); w.y = pk2(o[et][2] * il, o[et][3] * il);
        *(uint2*)(MIX + (size_t)qrow * DM + 512 + h * 64 + 16 * et + 4 * g) = w; }
}
#ifndef R2_MASK
#define R2_MASK 7
#endif
__device__ __forceinline__ void ph_r2(const Ctx& C, int l) {
    const int gw = C.vcu * NWAVES + C.wave, NGW = C.G * NWAVES;
    if (R2_MASK & 1) for (int id = gw; id < N_UNITS * 8; id += NGW) r2_ret_unit(C, l, id >> 3, id & 7);
    if (R2_MASK & 2) for (int id = gw; id < NB_CTX * 8 * 16; id += NGW) r2_ctx_unit(C, id >> 4, id & 15);
    if (R2_MASK & 4) for (int id = gw; id < NB_LAT * 8 * 64 * 4; id += NGW) r2_na_unit(C, l, id);
}
enum { PH_PRO = 0, PH_H0 = 1, PH_L0 = 2, PH_PER_LAYER = 10, PH_END = PH_L0 + NLAYER * PH_PER_LAYER };
enum { LP_GIN = 0, LP_R1 = 1, LP_R1B = 2, LP_R2 = 3, LP_GOUT = 4, LP_N1 = 5, LP_GUP = 6, LP_CG = 7, LP_GDOWN = 8, LP_N2 = 9 };
__global__ void __launch_bounds__(NTHREADS, 2) mk_fwd(Args a) {
    extern __shared__ __attribute__((aligned(16))) unsigned char lds_raw[];
    Ctx C;
    C.lds = (LAS unsigned char*)lds_raw;
    for (int u = threadIdx.x; u < (LDS_BYTES - LDSCTL_OFF) / 4; u += NTHREADS) ((LAS unsigned*)(C.lds + LDSCTL_OFF))[u] = 0u;
    __syncthreads();
    const bool multi = (a.ph_hi - a.ph_lo) > 1;
    XcdBarrier bar; bar.bar = (unsigned*)(a.ws + WS_CTL) + CW_BAR; bar.x = 0; bar.st = nullptr;
    if (multi) bar = xcd_barrier_post((unsigned*)(a.ws + WS_CTL) + CW_BAR, (volatile LAS unsigned*)(C.lds + MISC_OFF) + 8);


    for (int ph = a.ph_lo; ph < a.ph_hi; ++ph) {
        { KArgs kp = (KArgs)__builtin_amdgcn_kernarg_segment_ptr(); asm volatile("" : "+s"(kp)); C.ap = kp;
          int t = threadIdx.x; asm volatile("" : "+v"(t)); C.tid = t; C.lane = t & 63; C.wave = __builtin_amdgcn_readfirstlane(t >> 6);
          int bx = blockIdx.x; asm volatile("" : "+s"(bx)); C.bx = bx; C.G = gridDim.x; C.vcu = (C.G % 8 == 0) ? (bx % 8) * (C.G / 8) + bx / 8 : bx; }
        if (ph == PH_PRO) { ph_prologue(C); ph_cache_prep(C); }
        else if (ph == PH_H0) ph_norm_in(C);
        else {
            const int l = (ph - PH_L0) / PH_PER_LAYER, lp = (ph - PH_L0) % PH_PER_LAYER;
            unsigned char* ws = C.ap->ws; unsigned char* wl = ws + WS_W + (size_t)l * W_LAYER_BYTES;
            if (lp == LP_GIN) {
                pg8::Gemm g{(const bf16*)(ws + WS_HA), (const bf16*)(wl + W_IN_OFF), MROWS, NIN, DM}; pg8::StaticOrder S; S.init(MROWS, NIN, C.G, C.bx);
                EpiInF E{(bf16*)(ws + WS_BIG), C.ap->out, l};
                pg8::gemm_phase<EpiInF, pg8::StaticOrder, true, true>(C.lds, g, S, E, C.tid);
            } else if (lp == LP_R1) ph_r1(C, l);
            else if (lp == LP_R1B) ph_r1b(C, l);
            else if (lp == LP_R2) ph_r2(C, l);
            else if (lp == LP_GOUT) {
                pg8::Gemm g{(const bf16*)(ws + WS_BIG + BIG_MIX_OFF), (const bf16*)(wl + W_OUT_OFF), MROWS, DM, DM}; pg8::StaticOrder S; S.init(MROWS, DM, C.G, C.bx);
                EpiF32F E{(float*)(ws + WS_BIG), DM};
                pg8::gemm_phase<EpiF32F, pg8::StaticOrder, true, true>(C.lds, g, S, E, C.tid);
            } else if (lp == LP_N1) ph_post_norm(C, l, 0);
            else if (lp == LP_GUP) {
                pg8::Gemm g{(const bf16*)(ws + WS_HA), (const bf16*)(wl + W_UP_OFF), MROWS, NUP, DM}; pg8::StaticOrder S; S.init(MROWS, NUP, C.G, C.bx);
                EpiBfF E{(bf16*)(ws + WS_BIG), NUP};
                pg8::gemm_phase<EpiBfF, pg8::StaticOrder, true, true>(C.lds, g, S, E, C.tid);
            } else if (lp == LP_CG) ph_convgate(C, l);
            else if (lp == LP_GDOWN) {
                pg8::Gemm g{(const bf16*)(ws + WS_HA), (const bf16*)(wl + W_DOWN_OFF), MROWS, DM, NFF}; pg8::StaticOrder S; S.init(MROWS, DM, C.G, C.bx);
                EpiF32F E{(float*)(ws + WS_BIG), DM};
                pg8::gemm_phase<EpiF32F, pg8::StaticOrder, true, true>(C.lds, g, S, E, C.tid);
            } else if (lp == LP_N2) ph_post_norm(C, l, 1);
        }
        if (ph + 1 < a.ph_hi) xcd_barrier(bar);
    }
}

extern "C" void kernel_launch(void* const* d_in, const int* in_sizes, int n_in, void* d_out, int out_size, void* d_ws, size_t ws_size, hipStream_t stream) {
    static int grid = 0;
    if (grid == 0) {
        if (ws_size < WS_NEED || n_in != 23) { fprintf(stderr, "kernel_launch: unexpected sizes (ws %zu, n_in %d)\n", ws_size, n_in); grid = -1; return; }
        int dev = 0, cus = 0, per_cu = 0;
        if (hipGetDevice(&dev) != hipSuccess || hipDeviceGetAttribute(&cus, hipDeviceAttributeMultiprocessorCount, dev) != hipSuccess) { grid = -1; return; }
        if (hipFuncSetAttribute((const void*)mk_fwd, hipFuncAttributeMaxDynamicSharedMemorySize, LDS_BYTES) != hipSuccess) { fprintf(stderr, "kernel_launch: hipFuncSetAttribute failed\n"); grid = -1; return; }
        if (hipOccupancyMaxActiveBlocksPerMultiprocessor(&per_cu, (const void*)mk_fwd, NTHREADS, LDS_BYTES) != hipSuccess || per_cu < 1) { fprintf(stderr, "kernel_launch: occupancy query says %d\n", per_cu); per_cu = 1; }
        (void)hipGetLastError();
        grid = cus;
    }
    if (grid < 0) return;
    const float* x_prompt = (const float*)d_in[0]; const float* x_sample = (const float*)d_in[1];
    const float* cache_k = (const float*)d_in[3]; const float* cache_v = (const float*)d_in[4]; const float* st_f = (const float*)d_in[5]; const float* st_b = (const float*)d_in[6];
    const float* dec_f = (const float*)d_in[15]; const float* dec_b = (const float*)d_in[16]; const float* rpb = (const float*)d_in[17];
    float* out = (float*)d_out; unsigned char* ws = (unsigned char*)d_ws;
    bf16* P = (bf16*)(ws + WS_BIG); bf16* MIX = (bf16*)(ws + WS_BIG + BIG_MIX_OFF);
    (void)x_prompt; (void)x_sample; (void)cache_k; (void)cache_v; (void)st_f; (void)st_b; (void)dec_f; (void)dec_b; (void)rpb; (void)P; (void)MIX;
    (void)hipMemsetAsync(ws + WS_CTL, 0, CTL_BYTES, stream);
    Args a{};
    for (int i = 0; i < 23; ++i) a.in[i] = (const float*)d_in[i];
    a.out = out; a.ws = ws;
    auto run = [&](int lo, int hi) { a.ph_lo = lo; a.ph_hi = hi; hipLaunchKernelGGL(mk_fwd, dim3(grid), dim3(NTHREADS), LDS_BYTES, stream, a); };
    run(PH_PRO, PH_END);
}
```

```cpp
#include <hip/hip_runtime.h>
#include <cstdio>
#include <cstdint>

#define LAS __attribute__((address_space(3)))
typedef unsigned short bf16;
typedef short bf16x8 __attribute__((ext_vector_type(8)));
typedef float f32x4 __attribute__((ext_vector_type(4)));
typedef unsigned u32x4 __attribute__((ext_vector_type(4)));

constexpr int DM = 1024, M_CTX = 4096, M_LAT = 8192, MROWS = 12288;
constexpr int T_CTX = 256, T_LAT = 4096, NB_CTX = 16, NB_LAT = 2;
constexpr int NIN = 3584, NUP = 5632, NFF = 2816, NH = 8, HD = 64, NLAYER = 2, PAST = 512;
constexpr int C_RQ = 0, C_RK = 512, C_RV = 1024, C_RG = 1536, C_NQ = 2048, C_NK = 2560, C_NV = 3072;
constexpr float EPS = 1e-6f, LOG2E = 1.4426950408889634f;
constexpr size_t O_YP = 0, O_YS = 4194304, O_NK = 12582912, O_NV = 16777216, O_RF = 20971520, O_RB = 22020096;
constexpr size_t MiB = 1u << 20;
constexpr size_t WS_CTL = 0, CTL_BYTES = 1 * MiB;
constexpr size_t WS_MOD = 256 * 1024;
constexpr size_t WS_W = 1 * MiB;
constexpr size_t W_IN_OFF = 0, W_OUT_OFF = (size_t)NIN * DM * 2, W_UP_OFF = W_OUT_OFF + (size_t)DM * DM * 2, W_DOWN_OFF = W_UP_OFF + (size_t)NUP * DM * 2,
                 W_LAYER_BYTES = W_DOWN_OFF + (size_t)DM * NFF * 2;
static_assert(WS_W + 2 * W_LAYER_BYTES <= 52 * MiB, "weights");
constexpr size_t WS_HA = 52 * MiB;
constexpr size_t WS_BIG = 118 * MiB;
constexpr size_t BIG_MIX_OFF = 84 * MiB;
constexpr size_t WS_END = 250 * MiB;

__device__ __forceinline__ unsigned f2bf(float f) { unsigned u = __builtin_bit_cast(unsigned, f); return (u + 0x7fffu + ((u >> 16) & 1u)) >> 16; }
__device__ __forceinline__ float bf2f(bf16 h) { return __builtin_bit_cast(float, (unsigned)h << 16); }
__device__ __forceinline__ float silu_f(float x) { return x / (1.f + __expf(-x)); }
__device__ __forceinline__ float wave_sum(float v) {
#pragma unroll
    for (int o = 1; o < 64; o <<= 1) v += __shfl_xor(v, o);
    return v;
}
__device__ __forceinline__ float wave_max(float v) {
#pragma unroll
    for (int o = 1; o < 64; o <<= 1) v = fmaxf(v, __shfl_xor(v, o));
    return v;
}
__device__ __forceinline__ int cond_of_row(int row) { return row < M_CTX ? 0 : 1 + ((row - M_CTX) >> 12); }
__device__ __forceinline__ float log_sigmoid_f(float x) { return -log1pf(expf(-x)); }

namespace pg8 {
#define PG8_LAS __attribute__((address_space(3)))
typedef unsigned short bf16_t;
typedef short bf16x8 __attribute__((ext_vector_type(8)));
typedef float f32x4 __attribute__((ext_vector_type(4)));
typedef unsigned u32x4 __attribute__((ext_vector_type(4)));
constexpr int BM = 256, BK = 64, HALF = 128, HTB = HALF * BK * 2  , STAGE_BYTES = 8 * HTB, NXCD = 8, WGM = 8;

__host__ __device__ __forceinline__ int lds_byte(int r, int c) { const int st = (r >> 4) * 2 + (c >> 5), rr = r & 15, cc = c & 31, ob = rr * 64 + cc * 2; return st * 1024 + (ob ^ (((ob >> 9) & 1) << 5)); }
__host__ __device__ __forceinline__ void stage_rc(int b, int& R, int& C) { const int st = b / 1024, sb = b % 1024, swz = sb ^ (((sb >> 9) & 1) << 5); R = (st >> 1) * 16 + swz / 64; C = (st & 1) * 32 + (swz % 64) / 2; }
__host__ __device__ __forceinline__ int perm32(int rho) { const int n = rho >> 4, i = rho & 15; return 8 * (i >> 2) + 4 * n + (i & 3); }

struct Unit { int pm, pn; };
struct Gemm { const bf16_t* A; const bf16_t* Bt; int M, N, K; };

struct StaticOrder {
    int nM, nN, nwg, G, c;
    __host__ __device__ void init(int M, int N, int G_, int c_) { nM = M / BM; nN = N / BM; nwg = nM * nN; G = G_; c = c_; }
    __host__ __device__ bool next(int i, Unit& u) const {
        const long L = (long)i * G + c; if (L >= nwg) return false;
        int wgid = (int)L; { const int q = nwg / NXCD, r = nwg % NXCD, xcd = wgid % NXCD, off = wgid / NXCD; wgid = (xcd < r ? xcd * (q + 1) : r * (q + 1) + (xcd - r) * q) + off; }
        const int nig = WGM * nN, gid = wgid / nig, fm = gid * WGM, gsz = (nM - fm) < WGM ? (nM - fm) : WGM;
        u.pm = fm + ((wgid % nig) % gsz); u.pn = (wgid % nig) / gsz; return true;
    }
    __device__ __forceinline__ void a_ready(const Unit&) const {}
    __device__ __forceinline__ void done(const Unit&) const {}
};

__device__ __forceinline__ unsigned cvt_pk_bf16(float lo, float hi) { unsigned r; asm volatile("v_cvt_pk_bf16_f32 %0, %1, %2" : "=v"(r) : "v"(lo), "v"(hi)); return r; }
typedef float f32x2 __attribute__((ext_vector_type(2)));
template <class Epi, class Sched, bool ALIGN_EPI = false, bool SP2 = false>
__device__ __forceinline__ void gemm_phase(PG8_LAS unsigned char* lds, const Gemm g, const Sched& S, const Epi& E, const int tid_in) {
    const int tid = tid_in, wid = __builtin_amdgcn_readfirstlane(tid >> 6), lane = tid & 63, wr = wid >> 2, wc = wid & 3, fr = lane & 15, fq = lane >> 4;
    const int K = g.K, nt = K / BK;
    unsigned voffA[2], voffB[2];
#pragma unroll
    for (int i = 0; i < 2; ++i) { int R, C; stage_rc(tid * 16 + i * 8192, R, C); const int Rb = Epi::PERM ? ((R & ~31) + perm32(R & 31)) : R;
        voffA[i] = (unsigned)(R * K + C) * 2u; voffB[i] = (unsigned)(Rb * K + C) * 2u; }
    const size_t kstep = (size_t)(BK * 2);
    const size_t hstep = (size_t)HALF * K * 2;
    const size_t tstep = 2 * hstep;
    const unsigned ldsw = (unsigned)wid * 1024u;
    const int aoff = lds_byte(wr * 64 + fr, fq * 8), boff = lds_byte(wc * 32 + fr, fq * 8);
#define PG8_SA(b, h) (((b) * 2 + (h)) * HTB)
#define PG8_SB(b, h) ((4 + (b) * 2 + (h)) * HTB)
#define PG8_STAGE(bufoff, gbase, voff) do { _Pragma("unroll") for (int _i = 0; _i < 2; ++_i) \
        __builtin_amdgcn_global_load_lds((const unsigned*)((const char*)(gbase) + (voff)[_i]), (PG8_LAS unsigned*)(lds + (bufoff) + ldsw + _i * 8192), 16, 0, 0); } while (0)
#define PG8_LDA(dst, b, h) do { _Pragma("unroll") for (int m = 0; m < 4; ++m) _Pragma("unroll") for (int k = 0; k < 2; ++k) dst[m][k] = *(const PG8_LAS bf16x8*)(lds + PG8_SA(b, h) + aoff + m * 2048 + k * 1024); } while (0)
#define PG8_LDB(dst, b, h) do { _Pragma("unroll") for (int n = 0; n < 2; ++n) _Pragma("unroll") for (int k = 0; k < 2; ++k) dst[n][k] = *(const PG8_LAS bf16x8*)(lds + PG8_SB(b, h) + boff + n * 2048 + k * 1024); } while (0)
#define PG8_MMA(ai, bj, At, Bt) do { __builtin_amdgcn_s_setprio(1); _Pragma("unroll") for (int m = 0; m < 4; ++m) _Pragma("unroll") for (int n = 0; n < 2; ++n) _Pragma("unroll") for (int k = 0; k < 2; ++k) \
        acc[ai][bj][m][n] = __builtin_amdgcn_mfma_f32_16x16x32_bf16(Bt[n][k], At[m][k], acc[ai][bj][m][n], 0, 0, 0); __builtin_amdgcn_s_setprio(0); } while (0)
#define PG8_WAIT_V(n) asm volatile("s_waitcnt vmcnt(" #n ")" ::: "memory")
#define PG8_WAIT_L(n) asm volatile("s_waitcnt lgkmcnt(" #n ")" ::: "memory")
#define PG8_BAR __builtin_amdgcn_s_barrier()
#define PG8_SCHED __builtin_amdgcn_sched_barrier(0)
    Unit cur, nxt; int ui = 0;
    if (!S.next(0, cur)) return;
    f32x4 acc[2][2][4][2];
#pragma unroll
    for (int a = 0; a < 2; ++a)
#pragma unroll
        for (int b = 0; b < 2; ++b)
#pragma unroll
            for (int m = 0; m < 4; ++m)
#pragma unroll
                for (int n = 0; n < 2; ++n) acc[a][b][m][n] = (f32x4){0.f, 0.f, 0.f, 0.f};
    bf16x8 At[4][2], B0[2][2], B1[2][2];
    const char* cA = (const char*)g.A + (size_t)cur.pm * tstep; const char* cB = (const char*)g.Bt + (size_t)cur.pn * tstep;
    S.a_ready(cur);
    if constexpr (SP2) {
        PG8_STAGE(PG8_SB(0, 0), cB, voffB); PG8_STAGE(PG8_SB(0, 1), cB + hstep, voffB); PG8_STAGE(PG8_SA(0, 0), cA, voffA); PG8_STAGE(PG8_SA(0, 1), cA + hstep, voffA);
        if (wr == 1) PG8_BAR;
        PG8_WAIT_V(2); PG8_BAR;
        PG8_STAGE(PG8_SB(1, 0), cB + kstep, voffB); PG8_STAGE(PG8_SA(1, 0), cA + kstep, voffA); PG8_STAGE(PG8_SB(1, 1), cB + hstep + kstep, voffB);
        PG8_WAIT_V(6); PG8_BAR;
    } else {
        PG8_STAGE(PG8_SB(0, 0), cB, voffB); PG8_STAGE(PG8_SA(0, 0), cA, voffA); PG8_STAGE(PG8_SB(0, 1), cB + hstep, voffB); PG8_STAGE(PG8_SA(0, 1), cA + hstep, voffA);
        if (wr == 1) PG8_BAR;
        PG8_WAIT_V(4); PG8_BAR;
        PG8_STAGE(PG8_SB(1, 0), cB + kstep, voffB); PG8_STAGE(PG8_SA(1, 0), cA + kstep, voffA); PG8_STAGE(PG8_SB(1, 1), cB + hstep + kstep, voffB);
        PG8_WAIT_V(6); PG8_BAR;
    }
    for (;;) {
        const bool has_next = S.next(ui + 1, nxt);
        const char* nA = has_next ? (const char*)g.A + (size_t)nxt.pm * tstep : cA; const char* nB = has_next ? (const char*)g.Bt + (size_t)nxt.pn * tstep : cB;
        for (int t = 0; t < nt; t += 2) {
            const bool last = (t == nt - 2);
            const char* a1 = cA + (size_t)(t + 1) * kstep;
            const char* a2 = last ? nA : cA + (size_t)(t + 2) * kstep; const char* b2 = last ? nB : cB + (size_t)(t + 2) * kstep;
            const char* a3 = a2 + kstep; const char* b3 = b2 + kstep;
            if (last && has_next) S.a_ready(nxt);
            if constexpr (SP2) {
            PG8_LDB(B0, 0, 0); PG8_LDB(B1, 0, 1); PG8_SCHED; PG8_LDA(At, 0, 0); PG8_STAGE(PG8_SA(1, 1), a1 + hstep, voffA);
            PG8_WAIT_V(8); PG8_WAIT_L(0); PG8_BAR; PG8_MMA(0, 0, At, B0); PG8_MMA(0, 1, At, B1); PG8_BAR; PG8_SCHED;
            PG8_LDA(At, 0, 1); PG8_STAGE(PG8_SB(0, 0), b2, voffB); PG8_STAGE(PG8_SB(0, 1), b2 + hstep, voffB); PG8_STAGE(PG8_SA(0, 0), a2, voffA);
            PG8_WAIT_V(8); PG8_WAIT_L(0); PG8_BAR; PG8_MMA(1, 0, At, B0); PG8_MMA(1, 1, At, B1); PG8_BAR; PG8_SCHED;
            PG8_LDB(B0, 1, 0); PG8_LDB(B1, 1, 1); PG8_SCHED; PG8_LDA(At, 1, 0); PG8_STAGE(PG8_SA(0, 1), a2 + hstep, voffA);
            PG8_WAIT_V(8); PG8_WAIT_L(0); PG8_BAR; PG8_MMA(0, 0, At, B0); PG8_MMA(0, 1, At, B1); PG8_BAR; PG8_SCHED;
            PG8_LDA(At, 1, 1); PG8_STAGE(PG8_SB(1, 0), b3, voffB); PG8_STAGE(PG8_SB(1, 1), b3 + hstep, voffB); PG8_STAGE(PG8_SA(1, 0), a3, voffA);
            PG8_WAIT_V(8); PG8_WAIT_L(0); PG8_BAR; PG8_MMA(1, 0, At, B0); PG8_MMA(1, 1, At, B1); PG8_BAR; PG8_SCHED;
            } else {
            PG8_LDB(B0, 0, 0); PG8_SCHED; PG8_LDA(At, 0, 0); PG8_STAGE(PG8_SA(1, 1), a1 + hstep, voffA);
            PG8_WAIT_L(8); PG8_BAR; PG8_WAIT_L(0); PG8_MMA(0, 0, At, B0); PG8_BAR; PG8_SCHED;
            PG8_LDB(B1, 0, 1); PG8_STAGE(PG8_SB(0, 0), b2, voffB);
            PG8_BAR; PG8_WAIT_L(0); PG8_MMA(0, 1, At, B1); PG8_BAR;
            PG8_LDA(At, 0, 1); PG8_STAGE(PG8_SA(0, 0), a2, voffA);
            PG8_BAR; PG8_WAIT_L(0); PG8_MMA(1, 0, At, B0); PG8_BAR; PG8_SCHED;
            PG8_STAGE(PG8_SB(0, 1), b2 + hstep, voffB);
            PG8_WAIT_V(6); PG8_BAR; PG8_MMA(1, 1, At, B1); PG8_BAR;
            PG8_LDB(B0, 1, 0); PG8_SCHED; PG8_LDA(At, 1, 0); PG8_STAGE(PG8_SA(0, 1), a2 + hstep, voffA);
            PG8_WAIT_L(8); PG8_BAR; PG8_WAIT_L(0); PG8_MMA(0, 0, At, B0); PG8_BAR; PG8_SCHED;
            PG8_LDB(B1, 1, 1); PG8_STAGE(PG8_SB(1, 0), b3, voffB);
            PG8_BAR; PG8_WAIT_L(0); PG8_MMA(0, 1, At, B1); PG8_BAR;
            PG8_LDA(At, 1, 1); PG8_STAGE(PG8_SA(1, 0), a3, voffA);
            PG8_BAR; PG8_WAIT_L(0); PG8_MMA(1, 0, At, B0); PG8_BAR; PG8_SCHED;
            PG8_STAGE(PG8_SB(1, 1), b3 + hstep, voffB);
            PG8_WAIT_V(6); PG8_BAR; PG8_MMA(1, 1, At, B1); PG8_BAR;
            }
        }
        if constexpr (ALIGN_EPI) { if (wr == 0) PG8_BAR; }
        if constexpr (!Epi::AFTER_DRAIN) { E(acc, cur, wr, wc, fr, fq); S.done(cur); }
        if (!has_next) break;
#pragma unroll
        for (int a = 0; a < 2; ++a)
#pragma unroll
            for (int b = 0; b < 2; ++b)
#pragma unroll
                for (int m = 0; m < 4; ++m)
#pragma unroll
                    for (int n = 0; n < 2; ++n) acc[a][b][m][n] = (f32x4){0.f, 0.f, 0.f, 0.f};
        cur = nxt; cA = nA; cB = nB; ++ui;
        if constexpr (ALIGN_EPI) { if (wr == 1) PG8_BAR; }
    }
    PG8_WAIT_V(0);
    if constexpr (!ALIGN_EPI) { if (wr == 0) PG8_BAR; }
    PG8_BAR;
    if constexpr (Epi::AFTER_DRAIN) { E.fused(acc, cur, wr, wc, fr, fq, lds, wid, lane); S.done(cur); }
#undef PG8_SA
#undef PG8_SB
#undef PG8_STAGE
#undef PG8_LDA
#undef PG8_LDB
#undef PG8_MMA
#undef PG8_WAIT_V
#undef PG8_WAIT_L
#undef PG8_BAR
#undef PG8_SCHED
}
}
#define XB_TMO      128
#define XB_XCNT(j)  (256  + 64 * (j))
#define XB_XSUB(j)  (1280 + 64 * (j))
#define XB_XGEN(j)  (2304 + 64 * (j))
#define XB_TOP      3328
#define XB_TOPGEN   3392
#define XCD_BAR_WORDS 3456
#define XB_SPIN_CAP (1u << 18)

__device__ __forceinline__ unsigned xb_ld(unsigned* p)              { return __hip_atomic_load(p, __ATOMIC_RELAXED, __HIP_MEMORY_SCOPE_AGENT); }
__device__ __forceinline__ unsigned xb_add(unsigned* p, unsigned v) { return __hip_atomic_fetch_add(p, v, __ATOMIC_RELAXED, __HIP_MEMORY_SCOPE_AGENT); }
__device__ __forceinline__ unsigned xb_xcc_id() { return (unsigned)__builtin_amdgcn_s_getreg((3 << 11) | 20) & 0xFu; }
#define XB_SPIN(cond, bar) do { unsigned _sp = 0; while (cond) { __builtin_amdgcn_s_sleep(1); \
    if ((++_sp & 255u) == 0u) { if (xb_ld(&(bar)[XB_TMO])) break; if (_sp > XB_SPIN_CAP) { atomicAdd(&(bar)[XB_TMO], 1u); break; } } } } while (0)

struct XcdBarrier {
    unsigned* bar; unsigned x;
    volatile LAS unsigned* st;
};

__device__ __forceinline__ XcdBarrier xcd_barrier_post(unsigned* bar, volatile LAS unsigned* st) {
    XcdBarrier b; b.bar = bar; b.x = xb_xcc_id(); b.st = st;
    if (threadIdx.x == 0) (void)xb_add(&bar[XB_XCNT(b.x)], 1u);
    return b;
}
__device__ __forceinline__ void xcd_barrier_complete(unsigned* bar, unsigned x, unsigned& nloc, unsigned& nx) {
    const unsigned G = gridDim.x * gridDim.y * gridDim.z;
    unsigned sum, cnt, mine, sp = 0u;
    for (;;) {
        sum = 0u; cnt = 0u; mine = 0u;
#pragma unroll
        for (unsigned j = 0; j < 16; ++j) { const unsigned c = xb_ld(&bar[XB_XCNT(j)]); sum += c; cnt += (c > 0u) ? 1u : 0u; mine = (j == x) ? c : mine; }
        if (sum == G) break;
        __builtin_amdgcn_s_sleep(1);
        if ((++sp & 255u) == 0u) { if (xb_ld(&bar[XB_TMO])) break; if (sp > XB_SPIN_CAP) { atomicAdd(&bar[XB_TMO], 1u); break; } }
    }
    nloc = mine > 0u ? mine : 1u; nx = cnt > 0u ? cnt : 1u;
}

__device__ __forceinline__ void xcd_barrier(const XcdBarrier& b) {
    asm volatile("s_waitcnt vmcnt(0)" ::: "memory");
    __syncthreads();
    if (threadIdx.x == 0) {
        unsigned* bar = b.bar;
        __builtin_amdgcn_s_waitcnt(0);
        unsigned nloc = b.st[0], nx = b.st[1];
        if (nloc == 0u) { xcd_barrier_complete(bar, b.x, nloc, nx); b.st[0] = nloc; b.st[1] = nx; }
        const unsigned old = xb_add(&bar[XB_XSUB(b.x)], 1u);
        const unsigned gen = old / nloc;
        if (old + 1u == (gen + 1u) * nloc) {
            __builtin_amdgcn_fence(__ATOMIC_RELEASE, "agent");
            asm volatile("s_waitcnt vmcnt(0)" ::: "memory");
            const unsigned og = xb_add(&bar[XB_TOP], 1u);
            const unsigned tg = og / nx;
            if (og + 1u == (tg + 1u) * nx) xb_add(&bar[XB_TOPGEN], 1u);
            else XB_SPIN(xb_ld(&bar[XB_TOPGEN]) == tg, bar);
            __builtin_amdgcn_fence(__ATOMIC_ACQUIRE, "agent");
            xb_add(&bar[XB_XGEN(b.x)], 1u);
            asm volatile("s_waitcnt vmcnt(0)" ::: "memory");
        } else {
            XB_SPIN(xb_ld(&bar[XB_XGEN(b.x)]) == gen, bar);
            __builtin_amdgcn_fence(__ATOMIC_ACQUIRE, "agent");
            asm volatile("s_waitcnt vmcnt(0)" ::: "memory");
        }
    }
    __syncthreads();
}

constexpr int NWAVES = 8, NTHREADS = 512;
constexpr int RING_BYTES = 131072, LDSCTL_OFF = RING_BYTES, MISC_OFF = LDSCTL_OFF + 320, LDS_BYTES = 147456;
constexpr int CW_BAR = 4096;

struct Args { const float* in[23]; float* out; unsigned char* ws; int ph_lo, ph_hi; };
typedef const __attribute__((address_space(4))) Args* KArgs;
enum { I_XP = 0, I_XS = 1, I_C = 2, I_CK = 3, I_CV = 4, I_SF = 5, I_SB = 6, I_CCTX = 7, I_ADAW = 8, I_ADAB = 9, I_GPM = 10, I_GQM = 11, I_GPF = 12, I_GQF = 13,
       I_WIN = 14, I_DECF = 15, I_DECB = 16, I_RPB = 17, I_WOUT = 18, I_WUP = 19, I_CW = 20, I_CB = 21, I_WDOWN = 22 };
struct Ctx {
    LAS unsigned char* lds;
    int tid, lane, wave, G, vcu, bx;
    KArgs ap;
};
#define WSP(T, off) ((T*)(C.ap->ws + (off)))
#define INP(i) (C.ap->in[i])
__device__ __forceinline__ unsigned pk2(float lo, float hi) { return pg8::cvt_pk_bf16(lo, hi); }

struct EpiInF {
    static constexpr bool PERM = false, AFTER_DRAIN = false;
    bf16* P; float* out; int layer;
    __device__ __forceinline__ void operator()(const f32x4 (&acc)[2][2][4][2], const pg8::Unit& u, int wr, int wc, int fr, int fq) const {
        const int seg = u.pn >> 1; const bool lat = u.pm >= 16;
        const int row0 = u.pm * 256 + wr * 64 + fr;
        const int col0 = u.pn * 256 + wc * 32 + 4 * fq;
        const bool do_rope = lat && seg <= 1;
        float inv[4];
        { int fqq = fq; asm volatile("" : "+v"(fqq));
#pragma unroll
          for (int x = 0; x < 4; ++x) inv[x] = exp2f(-(float)(4 * fqq + x) * (13.287712379549449f / 16.f)); }
        const float qs = (seg == 0 || seg == 4) ? 0.125f : 1.f;
#pragma unroll
        for (int ai = 0; ai < 2; ++ai)
#pragma unroll
            for (int m = 0; m < 4; ++m) {
                const int row = row0 + ai * 128 + m * 16;
                float cs[4], sn[4];
                if (do_rope) {
                    const int t = (row - M_CTX) & (T_LAT - 1);
                    const float pos = (wc & 1) ? (float)(t & 63) : (float)(t >> 6);
#pragma unroll
                    for (int x = 0; x < 4; ++x) { const float ang = pos * inv[x]; cs[x] = __cosf(ang); sn[x] = __sinf(ang); }
                }
#pragma unroll
                for (int bj = 0; bj < 2; ++bj) {
                    f32x4 v0 = acc[ai][bj][m][0], v1 = acc[ai][bj][m][1];
                    if (do_rope) {
#pragma unroll
                        for (int x = 0; x < 4; ++x) { const float a = v0[x], b = v1[x]; v0[x] = a * cs[x] - b * sn[x]; v1[x] = a * sn[x] + b * cs[x]; }
                    }
                    v0 = v0 * qs; v1 = v1 * qs;
                    const int col = col0 + bj * 128;
                    if (!lat && seg >= 5) {
                        float* o = out + (seg == 5 ? O_NK : O_NV) + ((size_t)((u.pm * 2 + layer) * 256 + (row & 255))) * 512 + (col & 511);
                        *(f32x4*)o = v0; *(f32x4*)(o + 16) = v1;
                    }
                    bf16* p = P + (size_t)row * NIN + col;
                    uint2 w0, w1; w0.x = pk2(v0[0], v0[1]); w0.y = pk2(v0[2], v0[3]); w1.x = pk2(v1[0], v1[1]); w1.y = pk2(v1[2], v1[3]);
                    *(uint2*)p = w0; *(uint2*)(p + 16) = w1;
                }
            }
    }
};
struct EpiF32F {
    static constexpr bool PERM = false, AFTER_DRAIN = false;
    float* C; int ldc;
    __device__ __forceinline__ void operator()(const f32x4 (&acc)[2][2][4][2], const pg8::Unit& u, int wr, int wc, int fr, int fq) const {
        const int row0 = u.pm * 256 + wr * 64 + fr, col0 = u.pn * 256 + wc * 32 + 4 * fq;
#pragma unroll
        for (int ai = 0; ai < 2; ++ai)
#pragma unroll
            for (int m = 0; m < 4; ++m) { float* rowp = C + (size_t)(row0 + ai * 128 + m * 16) * ldc + col0;
#pragma unroll
                for (int bj = 0; bj < 2; ++bj)
#pragma unroll
                    for (int n = 0; n < 2; ++n) *(f32x4*)(rowp + bj * 128 + n * 16) = acc[ai][bj][m][n]; }
    }
};
struct EpiBfF {
    static constexpr bool PERM = true, AFTER_DRAIN = false;
    bf16* O; int ldc;
    __device__ __forceinline__ void operator()(const f32x4 (&acc)[2][2][4][2], const pg8::Unit& u, int wr, int wc, int fr, int fq) const {
        const int row0 = u.pm * 256 + wr * 64 + fr, col0 = u.pn * 256 + wc * 32 + 8 * fq;
#pragma unroll
        for (int ai = 0; ai < 2; ++ai)
#pragma unroll
            for (int m = 0; m < 4; ++m) { bf16* rowp = O + (size_t)(row0 + ai * 128 + m * 16) * ldc + col0;
#pragma unroll
                for (int bj = 0; bj < 2; ++bj) { const f32x4 v0 = acc[ai][bj][m][0], v1 = acc[ai][bj][m][1];
                    u32x4 w; w.x = pk2(v0[0], v0[1]); w.y = pk2(v0[2], v0[3]); w.z = pk2(v1[0], v1[1]); w.w = pk2(v1[2], v1[3]);
                    *(u32x4*)(rowp + bj * 128) = w; } }
    }
};

#ifndef MOD_DETERMINISTIC
#define MOD_DETERMINISTIC 0
#endif
constexpr int MOD_ITEMS = NLAYER * 24 * 8;
constexpr int TI_IN = (DM / 64) * (NIN / 32), TI_OUT = (DM / 64) * (DM / 32), TI_UP = (DM / 64) * (NUP / 32), TI_DOWN = (NFF / 64) * (DM / 32), TI_LAYER = TI_IN + TI_OUT + TI_UP + TI_DOWN;
__device__ __forceinline__ void mod_item(const Ctx& C, int it) {
    const int l = it / 192, rem = it % 192, cb = rem >> 3, kc = rem & 7;
    if (MOD_DETERMINISTIC && kc != 0) return;
    const int j0 = cb * 256 + C.lane * 4, k0 = kc * 128;
    f32x4 a0 = {0.f, 0.f, 0.f, 0.f}, a1 = a0, a2 = a0;
    const float* w = INP(I_ADAW) + ((size_t)l * DM + k0) * (6 * DM) + j0; const float* c_ctx = INP(I_CCTX); const float* cc = INP(I_C);
#pragma unroll 8
    for (int k = 0; k < (MOD_DETERMINISTIC ? 1024 : 128); ++k) {
        const f32x4 wv = *(const f32x4*)(w + (size_t)k * (6 * DM));
        const float s0 = silu_f(c_ctx[k0 + k]), s1 = silu_f(cc[k0 + k]), s2 = silu_f(cc[DM + k0 + k]);
        a0 += wv * s0; a1 += wv * s1; a2 += wv * s2;
    }
    if (kc == 0) { const f32x4 b = *(const f32x4*)(INP(I_ADAB) + l * 6 * DM + j0); a0 += b; a1 += b; a2 += b; }
    float* m0 = WSP(float, WS_MOD) + (size_t)(l * 3) * 6 * DM + j0;
    if (MOD_DETERMINISTIC) { *(f32x4*)m0 = a0; *(f32x4*)(m0 + 6 * DM) = a1; *(f32x4*)(m0 + 12 * DM) = a2; return; }
#pragma unroll
    for (int x = 0; x < 4; ++x) {
        __hip_atomic_fetch_add(m0 + x, a0[x], __ATOMIC_RELAXED, __HIP_MEMORY_SCOPE_AGENT);
        __hip_atomic_fetch_add(m0 + 6 * DM + x, a1[x], __ATOMIC_RELAXED, __HIP_MEMORY_SCOPE_AGENT);
        __hip_atomic_fetch_add(m0 + 12 * DM + x, a2[x], __ATOMIC_RELAXED, __HIP_MEMORY_SCOPE_AGENT);
    }
}
__device__ __forceinline__ void transpose_item(const float* W, int K, int N, bf16* WT, LAS float* scr, int item, int lane) {
    const int nblk = N / 32, kb = item / nblk, nb = item % nblk, k0 = 64 * kb, n0 = 32 * nb;
#pragma unroll 8
    for (int i = 0; i < 32; ++i) { const int kk = 2 * i + (lane >> 5); scr[kk * 33 + (lane & 31)] = W[(size_t)(k0 + kk) * N + n0 + (lane & 31)]; }
    asm volatile("s_waitcnt lgkmcnt(0)" ::: "memory");
    const int c = lane & 7;
#pragma unroll
    for (int j = 0; j < 4; ++j) { const int n = (lane >> 3) + 8 * j; const LAS float* s = scr + (8 * c) * 33 + n;
        u32x4 o; o.x = pk2(s[0 * 33], s[1 * 33]); o.y = pk2(s[2 * 33], s[3 * 33]); o.z = pk2(s[4 * 33], s[5 * 33]); o.w = pk2(s[6 * 33], s[7 * 33]);
        *(u32x4*)(WT + (size_t)(n0 + n) * K + k0 + 8 * c) = o; }
    asm volatile("s_waitcnt lgkmcnt(0)" ::: "memory");
}
__device__ __forceinline__ void ph_prologue(const Ctx& C) {
    LAS float* scr = (LAS float*)(C.lds + C.wave * 16384);
    const int gw = C.vcu * NWAVES + C.wave, NGW = C.G * NWAVES;
    for (int it = gw; it < MOD_ITEMS + NLAYER * TI_LAYER; it += NGW) {
        if (it < MOD_ITEMS) { mod_item(C, it); continue; }
        int r = it - MOD_ITEMS; const int l = r / TI_LAYER; r -= l * TI_LAYER;
        unsigned char* wl = C.ap->ws + WS_W + (size_t)l * W_LAYER_BYTES;
        if (r < TI_IN) { transpose_item(INP(I_WIN) + (size_t)l * DM * NIN, DM, NIN, (bf16*)(wl + W_IN_OFF), scr, r, C.lane); continue; } r -= TI_IN;
        if (r < TI_OUT) { transpose_item(INP(I_WOUT) + (size_t)l * DM * DM, DM, DM, (bf16*)(wl + W_OUT_OFF), scr, r, C.lane); continue; } r -= TI_OUT;
        if (r < TI_UP) { transpose_item(INP(I_WUP) + (size_t)l * DM * NUP, DM, NUP, (bf16*)(wl + W_UP_OFF), scr, r, C.lane); continue; } r -= TI_UP;
        transpose_item(INP(I_WDOWN) + (size_t)l * NFF * DM, NFF, DM, (bf16*)(wl + W_DOWN_OFF), scr, r, C.lane);
    }
}

__device__ __forceinline__ void store_h_row(bf16* hrow, int lane, const f32x4 (&x)[4], float rstd, const float* g, const float* sc, const float* sh) {
#pragma unroll
    for (int j = 0; j < 4; ++j) { const int c0 = 4 * lane + 256 * j;
        const f32x4 gv = *(const f32x4*)(g + c0), scv = *(const f32x4*)(sc + c0), shv = *(const f32x4*)(sh + c0);
        const f32x4 h = x[j] * rstd * gv * (scv + 1.f) + shv;
        uint2 w; w.x = pk2(h[0], h[1]); w.y = pk2(h[2], h[3]); *(uint2*)(hrow + c0) = w; }
}
__device__ __forceinline__ void ph_norm_in(const Ctx& C) {
    const int gw = C.vcu * NWAVES + C.wave, NGW = C.G * NWAVES;
    const float* x_prompt = INP(I_XP); const float* x_sample = INP(I_XS); const float* MOD = WSP(float, WS_MOD); const float* gpm = INP(I_GPM); bf16* H = WSP(bf16, WS_HA);
    for (int row = gw; row < MROWS; row += NGW) {
        const float* x = row < M_CTX ? x_prompt + (size_t)row * DM : x_sample + (size_t)(row - M_CTX) * DM;
        const float* md = MOD + (size_t)cond_of_row(row) * 6 * DM;
        f32x4 v[4]; float ss = 0.f;
#pragma unroll
        for (int j = 0; j < 4; ++j) { v[j] = *(const f32x4*)(x + 4 * C.lane + 256 * j); ss += (v[j][0] * v[j][0] + v[j][1] * v[j][1]) + (v[j][2] * v[j][2] + v[j][3] * v[j][3]); }
        const float rstd = rsqrtf(wave_sum(ss) * (1.f / DM) + EPS);
        store_h_row(H + (size_t)row * DM, C.lane, v, rstd, gpm, md + 1 * DM, md + 0 * DM);
    }
}
__device__ __forceinline__ void ph_post_norm(const Ctx& C, int l, int which) {
    const int gw = C.vcu * NWAVES + C.wave, NGW = C.G * NWAVES;
    const float* gpost = (which == 0 ? INP(I_GQM) : INP(I_GQF)) + l * DM;
    const bool has_next = (which == 0) || (l + 1 < NLAYER);
    const float* gnext = which == 0 ? INP(I_GPF) + l * DM : INP(I_GPM) + (l + 1) * DM;
    const int ga_idx = which == 0 ? 2 : 5, sh_idx = which == 0 ? 3 : 0, sc_idx = which == 0 ? 4 : 1, ln = which == 0 ? l : l + 1;
    float* X = C.ap->out; const float* x_prompt = INP(I_XP); const float* x_sample = INP(I_XS); const float* MOD = WSP(float, WS_MOD); const float* Y = WSP(float, WS_BIG); bf16* H = WSP(bf16, WS_HA);
    for (int row = gw; row < MROWS; row += NGW) {
        const float* xo = (which == 0 && l == 0) ? (row < M_CTX ? x_prompt + (size_t)row * DM : x_sample + (size_t)(row - M_CTX) * DM) : X + (size_t)row * DM;
        const int ci = cond_of_row(row);
        const float* md = MOD + (size_t)(l * 3 + ci) * 6 * DM;
        f32x4 y[4], x[4]; float ss = 0.f;
#pragma unroll
        for (int j = 0; j < 4; ++j) { y[j] = *(const f32x4*)(Y + (size_t)row * DM + 4 * C.lane + 256 * j); ss += (y[j][0] * y[j][0] + y[j][1] * y[j][1]) + (y[j][2] * y[j][2] + y[j][3] * y[j][3]); }
        const float rstd = rsqrtf(wave_sum(ss) * (1.f / DM) + EPS);
        float s2 = 0.f;
#pragma unroll
        for (int j = 0; j < 4; ++j) { const int c0 = 4 * C.lane + 256 * j;
            const f32x4 xv = *(const f32x4*)(xo + c0), gav = *(const f32x4*)(md + ga_idx * DM + c0), gp = *(const f32x4*)(gpost + c0);
            x[j] = xv + gav * (y[j] * rstd * gp);
            s2 += (x[j][0] * x[j][0] + x[j][1] * x[j][1]) + (x[j][2] * x[j][2] + x[j][3] * x[j][3]); }
#pragma unroll
        for (int j = 0; j < 4; ++j) *(f32x4*)(X + (size_t)row * DM + 4 * C.lane + 256 * j) = x[j];
        if (has_next) {
            const float* mn = MOD + (size_t)(ln * 3 + ci) * 6 * DM;
            const float r2 = rsqrtf(wave_sum(s2) * (1.f / DM) + EPS);
            store_h_row(H + (size_t)row * DM, C.lane, x, r2, gnext, mn + sc_idx * DM, mn + sh_idx * DM);
        }
    }
}
__device__ __forceinline__ void bf8_to_f(const bf16x8 v, float (&f)[8]) {
#pragma unroll
    for (int x = 0; x < 8; ++x) f[x] = bf2f((bf16)v[x]);
}
__device__ __forceinline__ void ph_convgate(const Ctx& C, int l) {
    const float* cw = INP(I_CW) + (size_t)l * 3 * NUP; const float* cb = INP(I_CB) + (size_t)l * NUP; const bf16* U = WSP(bf16, WS_BIG); bf16* ACT = WSP(bf16, WS_HA);
    constexpr int NCH = NFF / 8, NRUN = MROWS / 16;
    for (int it = C.vcu * NTHREADS + C.tid; it < NCH * NRUN; it += C.G * NTHREADS) {
        const int run = it / NCH, ch = it % NCH, j0 = ch * 8, r0 = run * 16;
        const int T = r0 < M_CTX ? T_CTX : T_LAT, t0 = r0 < M_CTX ? (r0 & (T_CTX - 1)) : ((r0 - M_CTX) & (T_LAT - 1));
        float wa[3][8], wg[3][8], ba[8], bg[8];
#pragma unroll
        for (int i = 0; i < 3; ++i)
#pragma unroll
            for (int x = 0; x < 8; ++x) { wa[i][x] = cw[i * NUP + j0 + x]; wg[i][x] = cw[i * NUP + NFF + j0 + x]; }
#pragma unroll
        for (int x = 0; x < 8; ++x) { ba[x] = cb[j0 + x]; bg[x] = cb[NFF + j0 + x]; }
        const bf16* u = U + (size_t)r0 * NUP + j0;
        float pa[8], pg[8], ca[8], cg[8], na[8], ng[8];
        if (t0 > 0) { bf8_to_f(*(const bf16x8*)(u - NUP), pa); bf8_to_f(*(const bf16x8*)(u - NUP + NFF), pg); }
        else {
#pragma unroll
            for (int x = 0; x < 8; ++x) { pa[x] = 0.f; pg[x] = 0.f; } }
        bf8_to_f(*(const bf16x8*)(u), ca); bf8_to_f(*(const bf16x8*)(u + NFF), cg);
#pragma unroll 4
        for (int r = 0; r < 16; ++r) {
            if (t0 + r + 1 < T) { bf8_to_f(*(const bf16x8*)(u + (size_t)(r + 1) * NUP), na); bf8_to_f(*(const bf16x8*)(u + (size_t)(r + 1) * NUP + NFF), ng); }
            else {
#pragma unroll
                for (int x = 0; x < 8; ++x) { na[x] = 0.f; ng[x] = 0.f; } }
            float o[8];
#pragma unroll
            for (int x = 0; x < 8; ++x) {
                const float a = ba[x] + wa[0][x] * pa[x] + wa[1][x] * ca[x] + wa[2][x] * na[x];
                const float g = bg[x] + wg[0][x] * pg[x] + wg[1][x] * cg[x] + wg[2][x] * ng[x];
                o[x] = silu_f(g) * a; pa[x] = ca[x]; pg[x] = cg[x]; ca[x] = na[x]; cg[x] = ng[x];
            }
            u32x4 w; w.x = pk2(o[0], o[1]); w.y = pk2(o[2], o[3]); w.z = pk2(o[4], o[5]); w.w = pk2(o[6], o[7]);
            *(u32x4*)(ACT + (size_t)(r0 + r) * NFF + j0) = w;
        }
    }
}
constexpr size_t HA_VTR = 0, HA_VTN = 12 * MiB, HA_UST = 24 * MiB, HA_SST = 48 * MiB;
constexpr size_t VT_LAT_OFF = (size_t)NB_CTX * 512 * T_CTX;
constexpr size_t WS_CKB = 250 * MiB, WS_CVT = 252 * MiB, WS_NEED = 254 * MiB;
constexpr int N_UNITS = 768;
#ifndef NA_SKIP_CTX
#define NA_SKIP_CTX 0
#endif
#define MFMA16(A, B, Cc) __builtin_amdgcn_mfma_f32_16x16x32_bf16(A, B, Cc, 0, 0, 0)

__device__ __forceinline__ bf16x8 ld16(const bf16* p) { return *(const bf16x8*)p; }
__device__ __forceinline__ bf16x8 ld8x2(const bf16* p0, const bf16* p1) { const uint2 a = *(const uint2*)p0, b = *(const uint2*)p1; const u32x4 w = {a.x, a.y, b.x, b.y}; return __builtin_bit_cast(bf16x8, w); }
__device__ __forceinline__ bf16x8 pack8(const f32x4 lo, const f32x4 hi) { const u32x4 w = {pk2(lo[0], lo[1]), pk2(lo[2], lo[3]), pk2(hi[0], hi[1]), pk2(hi[2], hi[3])}; return __builtin_bit_cast(bf16x8, w); }
__device__ __forceinline__ float red4(float v) { v += __shfl_xor(v, 16); v += __shfl_xor(v, 32); return v; }
__device__ __forceinline__ float max4(float v) { v = fmaxf(v, __shfl_xor(v, 16)); v = fmaxf(v, __shfl_xor(v, 32)); return v; }
struct UnitInfo { int lat, b, h, c, T, rowbase, tpos; };
__device__ __forceinline__ UnitInfo unit_info(int uid) {
    UnitInfo u;
    if (uid < 256) { u.lat = 0; u.c = uid & 1; u.h = (uid >> 1) & 7; u.b = uid >> 4; u.T = T_CTX; u.tpos = u.c * 128; u.rowbase = u.b * 256 + u.tpos; }
    else { const int v = uid - 256; u.lat = 1; u.c = v & 31; u.h = (v >> 5) & 7; u.b = v >> 8; u.T = T_LAT; u.tpos = u.c * 128; u.rowbase = M_CTX + u.b * 4096 + u.tpos; }
    return u;
}
__device__ __forceinline__ const bf16* vt_row(const bf16* VT, int lat, int b, int h, int e) {
    return lat ? VT + VT_LAT_OFF + ((size_t)((b * 8 + h) * 64 + e)) * T_LAT : VT + ((size_t)((b * 8 + h) * 64 + e)) * T_CTX;
}

__device__ __forceinline__ void ph_cache_prep(const Ctx& C) {
    const float* ck = INP(I_CK); const float* cv = INP(I_CV); bf16* CKB = WSP(bf16, WS_CKB); bf16* CVT = WSP(bf16, WS_CVT);
    for (int id = C.vcu * NTHREADS + C.tid; id < 131072; id += C.G * NTHREADS) {
        { const int d8 = id & 7, h = (id >> 3) & 7, n = (id >> 6) & 511, bl = id >> 15;
          const float* s = ck + ((size_t)((bl * PAST + n) * 8 + h)) * 64 + d8 * 8;
          const f32x4 a = *(const f32x4*)s, b = *(const f32x4*)(s + 4);
          const u32x4 w = {pk2(a[0], a[1]), pk2(a[2], a[3]), pk2(b[0], b[1]), pk2(b[2], b[3])};
          *(u32x4*)(CKB + ((size_t)((bl * 8 + h) * PAST + n)) * 64 + d8 * 8) = w; }
        { const int e = id & 63, nch = (id >> 6) & 63, h = (id >> 12) & 7, bl = id >> 15;
          const float* s = cv + ((size_t)((bl * PAST + nch * 8) * 8 + h)) * 64 + e; float v[8];
#pragma unroll
          for (int x = 0; x < 8; ++x) v[x] = s[(size_t)x * 512];
          const u32x4 w = {pk2(v[0], v[1]), pk2(v[2], v[3]), pk2(v[4], v[5]), pk2(v[6], v[7])};
          *(u32x4*)(CVT + ((size_t)((bl * 8 + h) * 64 + e)) * PAST + nch * 8) = w; }
    }
}

__device__ __forceinline__ void r1_state_unit(const Ctx& C, int l, int uid) {
    const UnitInfo u = unit_info(uid);
    const bf16* P = WSP(bf16, WS_BIG); float* UST = WSP(float, WS_HA + HA_UST);
    const float lgf2 = log_sigmoid_f(INP(I_DECF)[l * 8 + u.h]) * LOG2E, lgb2 = log_sigmoid_f(INP(I_DECB)[l * 8 + u.h]) * LOG2E;
    LAS float* Kf = (LAS float*)C.lds; LAS float* Kb = Kf + 8192; LAS float* Vs = Kf + 16384;
    { const int jr = C.tid >> 2, seg = C.tid & 3;
      const bf16* kp = P + (size_t)(u.rowbase + jr) * NIN + C_RK + u.h * 64 + seg * 16; const bf16* vp = P + (size_t)(u.rowbase + jr) * NIN + C_RV + u.h * 64 + seg * 16;
      const float wf = exp2f(lgf2 * (float)(127 - jr)), wb = exp2f(lgb2 * (float)jr);
#pragma unroll
      for (int q = 0; q < 2; ++q) { const bf16x8 kv = ld16(kp + 8 * q), vv = ld16(vp + 8 * q); float kf[8], vf[8]; bf8_to_f(kv, kf); bf8_to_f(vv, vf);
#pragma unroll
          for (int x4 = 0; x4 < 2; ++x4) { const int o = jr * 64 + seg * 16 + q * 8 + x4 * 4;
              *(LAS f32x4*)(Kf + o) = (f32x4){kf[4 * x4] * wf, kf[4 * x4 + 1] * wf, kf[4 * x4 + 2] * wf, kf[4 * x4 + 3] * wf};
              *(LAS f32x4*)(Kb + o) = (f32x4){kf[4 * x4] * wb, kf[4 * x4 + 1] * wb, kf[4 * x4 + 2] * wb, kf[4 * x4 + 3] * wb};
              *(LAS f32x4*)(Vs + o) = (f32x4){vf[4 * x4], vf[4 * x4 + 1], vf[4 * x4 + 2], vf[4 * x4 + 3]}; } } }
    __syncthreads();
    const int ep = C.tid & 31, dq = C.tid >> 5;
    f32x4 af0 = {0.f, 0.f, 0.f, 0.f}, af1 = af0, ab0 = af0, ab1 = af0;
#pragma unroll 4
    for (int j = 0; j < 128; ++j) {
        const float v0 = Vs[j * 64 + 2 * ep], v1 = Vs[j * 64 + 2 * ep + 1];
        const f32x4 kf = *(const LAS f32x4*)(Kf + j * 64 + 4 * dq), kb = *(const LAS f32x4*)(Kb + j * 64 + 4 * dq);
        af0 += kf * v0; af1 += kf * v1; ab0 += kb * v0; ab1 += kb * v1;
    }
    float* uf = UST + ((size_t)(uid * 2 + 0)) * 4096 + (2 * ep) * 64 + 4 * dq; float* ub = uf + 4096;
    *(f32x4*)uf = af0; *(f32x4*)(uf + 64) = af1; *(f32x4*)ub = ab0; *(f32x4*)(ub + 64) = ab1;
    __syncthreads();
}
__device__ __forceinline__ void r1_transpose_item(const Ctx& C, int id) {
    const int which = id / 1536, rem = id % 1536, tb = rem >> 3, h = rem & 7, row0 = tb * 64;
    const bf16* P = WSP(bf16, WS_BIG); bf16* VT = WSP(bf16, WS_HA + (which ? HA_VTN : HA_VTR));
    const int col = (which ? C_NV : C_RV) + h * 64;
    const int lat = row0 >= M_CTX, b = lat ? (row0 - M_CTX) >> 12 : row0 >> 8, t0 = lat ? (row0 - M_CTX) & 4095 : row0 & 255;
    LAS unsigned* tile = (LAS unsigned*)(C.lds + C.wave * 16384);
#pragma unroll
    for (int i = 0; i < 4; ++i) { const int tp = i * 8 + (C.lane >> 3), e0 = (C.lane & 7) * 8;
        const bf16x8 a = ld16(P + (size_t)(row0 + 2 * tp) * NIN + col + e0), bb = ld16(P + (size_t)(row0 + 2 * tp + 1) * NIN + col + e0);
#pragma unroll
        for (int x = 0; x < 8; ++x) tile[(e0 + x) * 36 + tp] = (unsigned)(unsigned short)a[x] | ((unsigned)(unsigned short)bb[x] << 16); }
    asm volatile("s_waitcnt lgkmcnt(0)" ::: "memory");
#pragma unroll
    for (int i = 0; i < 8; ++i) { const int e = i * 8 + (C.lane >> 3), ch = C.lane & 7;
        const u32x4 v = *(const LAS u32x4*)(tile + e * 36 + ch * 4);
        *(u32x4*)((bf16*)vt_row(VT, lat, b, h, e) + t0 + 8 * ch) = v; }
    asm volatile("s_waitcnt lgkmcnt(0)" ::: "memory");
}
__device__ __forceinline__ void ph_r1(const Ctx& C, int l) {
    for (int uid = C.vcu; uid < N_UNITS; uid += C.G) r1_state_unit(C, l, uid);
    const int gw = C.vcu * NWAVES + C.wave, NGW = C.G * NWAVES;
    for (int id = gw; id < 3072; id += NGW) r1_transpose_item(C, id);
}
__device__ __forceinline__ void ph_r1b(const Ctx& C, int l) {
    const float* UST = WSP(float, WS_HA + HA_UST); bf16* SST = WSP(bf16, WS_HA + HA_SST); float* out = C.ap->out;
    const float* decf = INP(I_DECF) + l * 8; const float* decb = INP(I_DECB) + l * 8;
    for (int gid = C.vcu * NTHREADS + C.tid; gid < 131072 + 1048576; gid += C.G * NTHREADS) {
        if (gid < 131072) {
            const int elem = gid & 4095, dir = (gid >> 12) & 1, bh = gid >> 13, h = bh & 7, b = bh >> 3, e = elem >> 6, d = elem & 63;
            const float gC = exp2f(log_sigmoid_f((dir ? decb : decf)[h]) * LOG2E * 128.f);
            float s = (dir ? INP(I_SB) : INP(I_SF))[((size_t)((b * 2 + l) * 8 + h)) * 4096 + d * 64 + e];
            const int u0 = 256 + bh * 32;
            for (int i = 0; i < 32; ++i) { const int c = dir ? 31 - i : i; const size_t o = ((size_t)((u0 + c) * 2 + dir)) * 4096 + elem;
                SST[o] = (bf16)f2bf(s); s = s * gC + UST[o]; }
        } else {
            const int g2 = gid - 131072, elem = g2 & 4095, dir = (g2 >> 12) & 1, bh = g2 >> 13, h = bh & 7, b = bh >> 3, e = elem >> 6, d = elem & 63;
            const float gC = exp2f(log_sigmoid_f((dir ? decb : decf)[h]) * LOG2E * 128.f);
            const size_t o0 = ((size_t)((bh * 2 + 0) * 2 + dir)) * 4096 + elem, o1 = ((size_t)((bh * 2 + 1) * 2 + dir)) * 4096 + elem;
            const float u0 = UST[o0], u1 = UST[o1];
            float fin;
            if (dir == 0) { SST[o0] = 0; SST[o1] = (bf16)f2bf(u0); fin = u1 + gC * u0; }
            else { SST[o1] = 0; SST[o0] = (bf16)f2bf(u1); fin = u0 + gC * u1; }
            out[(dir ? O_RB : O_RF) + ((size_t)((b * 2 + l) * 8 + h)) * 4096 + d * 64 + e] = fin;
        }
    }
}
__device__ __forceinline__ void r2_ret_unit(const Ctx& C, int l, int uid, int qg) {
    const UnitInfo u = unit_info(uid);
    const bf16* P = WSP(bf16, WS_BIG); const bf16* VT = WSP(bf16, WS_HA + HA_VTR); const bf16* SST = WSP(bf16, WS_HA + HA_SST); bf16* MIX = WSP(bf16, WS_BIG + BIG_MIX_OFF);
    const float lgf2 = log_sigmoid_f(INP(I_DECF)[l * 8 + u.h]) * LOG2E, lgb2 = log_sigmoid_f(INP(I_DECB)[l * 8 + u.h]) * LOG2E;
    const int fr = C.lane & 15, g = C.lane >> 4, qi = 16 * qg + fr, qrow = u.rowbase + qi;
    const bf16* qp = P + (size_t)qrow * NIN + C_RQ + u.h * 64 + 8 * g;
    const bf16x8 q0 = ld16(qp), q1 = ld16(qp + 32);
    f32x4 s[8];
#pragma unroll
    for (int jt = 0; jt < 8; ++jt) { const bf16* kp = P + (size_t)(u.rowbase + 16 * jt + fr) * NIN + C_RK + u.h * 64 + 8 * g;
        const bf16x8 k0 = ld16(kp), k1 = ld16(kp + 32);
        f32x4 a = {0.f, 0.f, 0.f, 0.f}; a = MFMA16(k0, q0, a); a = MFMA16(k1, q1, a);
#pragma unroll
        for (int r = 0; r < 4; ++r) { const int dd = qi - (16 * jt + 4 * g + r);
            const float w = (dd >= 0 ? exp2f(lgf2 * (float)dd) : 0.f) + (dd <= 0 ? exp2f(lgb2 * (float)(-dd)) : 0.f); a[r] *= w; }
        s[jt] = a; }
    f32x4 o[4];
#pragma unroll
    for (int et = 0; et < 4; ++et) o[et] = (f32x4){0.f, 0.f, 0.f, 0.f};
#pragma unroll
    for (int kk = 0; kk < 4; ++kk) { const bf16x8 pb = pack8(s[2 * kk], s[2 * kk + 1]);
#pragma unroll
        for (int et = 0; et < 4; ++et) { const bf16* vp = vt_row(VT, u.lat, u.b, u.h, 16 * et + fr) + u.tpos + 32 * kk + 4 * g;
            o[et] = MFMA16(ld8x2(vp, vp + 16), pb, o[et]); } }
    const float qdf = exp2f(lgf2 * (float)(qi + 1)), qdb = exp2f(lgb2 * (float)(128 - qi));
#pragma unroll
    for (int et = 0; et < 4; ++et) { const bf16* sp = SST + ((size_t)(uid * 2)) * 4096 + (16 * et + fr) * 64 + 8 * g;
        f32x4 cf = {0.f, 0.f, 0.f, 0.f}, cb = cf;
        cf = MFMA16(ld16(sp), q0, cf); cf = MFMA16(ld16(sp + 32), q1, cf);
        cb = MFMA16(ld16(sp + 4096), q0, cb); cb = MFMA16(ld16(sp + 4096 + 32), q1, cb);
        o[et] += cf * qdf + cb * qdb; }
    float sum = 0.f;
#pragma unroll
    for (int et = 0; et < 4; ++et) sum += (o[et][0] + o[et][1]) + (o[et][2] + o[et][3]);
    const float mu = red4(sum) * (1.f / 64.f);
    float sq = 0.f;
#pragma unroll
    for (int et = 0; et < 4; ++et) { o[et] = o[et] - mu; sq += (o[et][0] * o[et][0] + o[et][1] * o[et][1]) + (o[et][2] * o[et][2] + o[et][3] * o[et][3]); }
    const float rstd = rsqrtf(red4(sq) * (1.f / 64.f) + EPS);
#pragma unroll
    for (int et = 0; et < 4; ++et) { const int e0 = u.h * 64 + 16 * et + 4 * g;
        const uint2 gw = *(const uint2*)(P + (size_t)qrow * NIN + C_RG + e0);
        const float g0 = __builtin_bit_cast(float, gw.x << 16), g1 = __builtin_bit_cast(float, gw.x & 0xffff0000u), g2 = __builtin_bit_cast(float, gw.y << 16), g3 = __builtin_bit_cast(float, gw.y & 0xffff0000u);
        uint2 w; w.x = pk2(o[et][0] * rstd * silu_f(g0), o[et][1] * rstd * silu_f(g1)); w.y = pk2(o[et][2] * rstd * silu_f(g2), o[et][3] * rstd * silu_f(g3));
        *(uint2*)(MIX + (size_t)qrow * DM + e0) = w; }
}
#define SOFTMAX_CHUNK(s2, NT) do { float cm_ = -1e30f; \
    _Pragma("unroll") for (int t_ = 0; t_ < NT; ++t_) cm_ = fmaxf(cm_, fmaxf(fmaxf(s2[t_][0], s2[t_][1]), fmaxf(s2[t_][2], s2[t_][3]))); \
    cm_ = max4(cm_); const float mn_ = fmaxf(m, cm_); const float al_ = exp2f(m - mn_); float cs_ = 0.f; \
    _Pragma("unroll") for (int t_ = 0; t_ < NT; ++t_) { _Pragma("unroll") for (int r_ = 0; r_ < 4; ++r_) { const float p_ = exp2f(s2[t_][r_] - mn_); s2[t_][r_] = p_; cs_ += p_; } } \
    lsum = lsum * al_ + red4(cs_); m = mn_; \
    _Pragma("unroll") for (int et_ = 0; et_ < 4; ++et_) o[et_] = o[et_] * al_; } while (0)

__device__ __forceinline__ void r2_ctx_unit(const Ctx& C, int bh, int qg) {
    const int b = bh >> 3, h = bh & 7, fr = C.lane & 15, g = C.lane >> 4, rowbase = b * 256, qrow = rowbase + 16 * qg + fr;
    const bf16* P = WSP(bf16, WS_BIG); const bf16* VT = WSP(bf16, WS_HA + HA_VTN); bf16* MIX = WSP(bf16, WS_BIG + BIG_MIX_OFF);
    const bf16* qp = P + (size_t)qrow * NIN + C_NQ + h * 64 + 8 * g;
    const bf16x8 q0 = ld16(qp), q1 = ld16(qp + 32);
    f32x4 s[16];
#pragma unroll
    for (int jt = 0; jt < 16; ++jt) { const bf16* kp = P + (size_t)(rowbase + 16 * jt + fr) * NIN + C_NK + h * 64 + 8 * g;
        f32x4 a = {0.f, 0.f, 0.f, 0.f}; a = MFMA16(ld16(kp), q0, a); a = MFMA16(ld16(kp + 32), q1, a); s[jt] = a * LOG2E; }
    float m = -1e30f, lsum = 0.f; f32x4 o[4];
#pragma unroll
    for (int et = 0; et < 4; ++et) o[et] = (f32x4){0.f, 0.f, 0.f, 0.f};
    SOFTMAX_CHUNK(s, 16);
#pragma unroll
    for (int kk = 0; kk < 8; ++kk) { const bf16x8 pb = pack8(s[2 * kk], s[2 * kk + 1]);
#pragma unroll
        for (int et = 0; et < 4; ++et) { const bf16* vp = vt_row(VT, 0, b, h, 16 * et + fr) + 32 * kk + 4 * g; o[et] = MFMA16(ld8x2(vp, vp + 16), pb, o[et]); } }
    const float il = 1.f / lsum;
#pragma unroll
    for (int et = 0; et < 4; ++et) { uint2 w; w.x = pk2(o[et][0] * il, o[et][1] * il); w.y = pk2(o[et][2] * il, o[et][3] * il);
        *(uint2*)(MIX + (size_t)qrow * DM + 512 + h * 64 + 16 * et + 4 * g) = w; }
}
__device__ __forceinline__ void r2_na_unit(const Ctx& C, int l, int id) {
    const int jb = id & 3, r = (id >> 2) & 63, h = (id >> 8) & 7, b = id >> 11, fr = C.lane & 15, g = C.lane >> 4;
    const bf16* P = WSP(bf16, WS_BIG); const bf16* VT = WSP(bf16, WS_HA + HA_VTN); bf16* MIX = WSP(bf16, WS_BIG + BIG_MIX_OFF);
    const bf16* CKB = WSP(bf16, WS_CKB); const bf16* CVT = WSP(bf16, WS_CVT); const float* rpb = INP(I_RPB) + (size_t)(l * 8 + h) * 15 * 31;
    const int rs = min(max(r - 4, 0), 56), kb = min(max(16 * jb - 8, 0), 32), qc = 16 * jb + fr, cs = min(max(qc - 8, 0), 48);
    const int latbase = M_CTX + b * 4096, qrow = latbase + r * 64 + qc;
    const bf16* qp = P + (size_t)qrow * NIN + C_NQ + h * 64 + 8 * g;
    const bf16x8 q0 = ld16(qp), q1 = ld16(qp + 32);
    float m = -1e30f, lsum = 0.f; f32x4 o[4];
#pragma unroll
    for (int et = 0; et < 4; ++et) o[et] = (f32x4){0.f, 0.f, 0.f, 0.f};
    f32x4 s[16];
#pragma unroll
    for (int tl = 0; tl < 16; ++tl) { const int kr = tl >> 1, hf = tl & 1;
        const bf16* kp = P + (size_t)(latbase + (rs + kr) * 64 + kb + 16 * hf + fr) * NIN + C_NK + h * 64 + 8 * g;
        f32x4 a = {0.f, 0.f, 0.f, 0.f}; a = MFMA16(ld16(kp), q0, a); a = MFMA16(ld16(kp + 32), q1, a);
#pragma unroll
        for (int rr = 0; rr < 4; ++rr) { const int kc = kb + 16 * hf + 4 * g + rr; const bool ok = (kc >= cs) && (kc < cs + 16);
            const float bias = rpb[ok ? ((rs + kr - r + 7) * 31 + (kc - qc + 15)) : 0];
            a[rr] = ok ? (a[rr] + bias) * LOG2E : -1e30f; }
        s[tl] = a; }
    SOFTMAX_CHUNK(s, 16);
#pragma unroll
    for (int kr = 0; kr < 8; ++kr) { const bf16x8 pb = pack8(s[2 * kr], s[2 * kr + 1]);
#pragma unroll
        for (int et = 0; et < 4; ++et) { const bf16* vp = vt_row(VT, 1, b, h, 16 * et + fr) + (rs + kr) * 64 + kb + 4 * g; o[et] = MFMA16(ld8x2(vp, vp + 16), pb, o[et]); } }
#pragma unroll 1
    for (int n0 = 0; n0 < (NA_SKIP_CTX ? 0 : PAST); n0 += 256) {
#pragma unroll
        for (int tl = 0; tl < 16; ++tl) { const bf16* kp = CKB + ((size_t)(((b * 2 + l) * 8 + h) * PAST + n0 + 16 * tl + fr)) * 64 + 8 * g;
            f32x4 a = {0.f, 0.f, 0.f, 0.f}; a = MFMA16(ld16(kp), q0, a); a = MFMA16(ld16(kp + 32), q1, a); s[tl] = a * LOG2E; }
        SOFTMAX_CHUNK(s, 16);
#pragma unroll
        for (int kk = 0; kk < 8; ++kk) { const bf16x8 pb = pack8(s[2 * kk], s[2 * kk + 1]);
#pragma unroll
            for (int et = 0; et < 4; ++et) { const bf16* vp = CVT + ((size_t)(((b * 2 + l) * 8 + h) * 64 + 16 * et + fr)) * PAST + n0 + 32 * kk + 4 * g; o[et] = MFMA16(ld8x2(vp, vp + 16), pb, o[et]); } }
    }
    const float il = 1.f / lsum;
#pragma unroll
    for (int et = 0; et < 4; ++et) { uint2 w; w.x = pk2(o[et][0] * il, o[et][1] * il); w.y = pk2(o[et][2] * il, o[et][3] * il);
        *(uint2*)(MIX + (size_t)qrow * DM + 512 + h * 64 + 16 * et + 4 * g) = w; }
}
#ifndef R2_MASK
#define R2_MASK 7
#endif
__device__ __forceinline__ void ph_r2(const Ctx& C, int l) {
    const int gw = C.vcu * NWAVES + C.wave, NGW = C.G * NWAVES;
    if (R2_MASK & 1) for (int id = gw; id < N_UNITS * 8; id += NGW) r2_ret_unit(C, l, id >> 3, id & 7);
    if (R2_MASK & 2) for (int id = gw; id < NB_CTX * 8 * 16; id += NGW) r2_ctx_unit(C, id >> 4, id & 15);
    if (R2_MASK & 4) for (int id = gw; id < NB_LAT * 8 * 64 * 4; id += NGW) r2_na_unit(C, l, id);
}
typedef LAS unsigned char* lds_p;
typedef unsigned u32x2 __attribute__((ext_vector_type(2)));
__device__ __forceinline__ bf16x8 ldsk(lds_p base, int key, int c) { return *(const LAS bf16x8*)(base + key * 128 + ((c ^ ((key >> 1) & 7)) << 4)); }
__device__ __forceinline__ bf16x8 ldsvt_swz(lds_p base, int e, int rb, int c8) {
    const u32x2 a = *(const LAS u32x2*)(base + e * rb + ((c8 ^ (2 * (e & 15))) << 3)), b = *(const LAS u32x2*)(base + e * rb + (((c8 + 4) ^ (2 * (e & 15))) << 3));
    const u32x4 w = {a.x, a.y, b.x, b.y}; return __builtin_bit_cast(bf16x8, w); }
__device__ __forceinline__ bf16x8 ldsvt_lin(lds_p base, int e, int stride, int key0) {
    const u32x2 a = *(const LAS u32x2*)(base + e * stride + key0 * 2), b = *(const LAS u32x2*)(base + e * stride + (key0 + 16) * 2);
    const u32x4 w = {a.x, a.y, b.x, b.y}; return __builtin_bit_cast(bf16x8, w); }
__device__ __forceinline__ bf16x8 ldsk144(lds_p base, int key, int c) { return *(const LAS bf16x8*)(base + key * 144 + c * 16); }
__device__ __forceinline__ bf16x8 ldsvt_blk(lds_p base, int blk, int e, int g) {
    const int x = 2 * ((e >> 2) & 3);
    const u32x2 a = *(const LAS u32x2*)(base + blk * 4096 + e * 64 + ((g ^ x) << 3)), b = *(const LAS u32x2*)(base + blk * 4096 + e * 64 + (((g + 4) ^ x) << 3));
    const u32x4 w = {a.x, a.y, b.x, b.y}; return __builtin_bit_cast(bf16x8, w); }
#define STAGE_VT_BLK(dstbase, NK, ROWP) do { constexpr int CPR_ = (NK) / 8, NI_ = 64 * CPR_ / NTHREADS; u32x4 t_[NI_]; int tid_ = C.tid; asm volatile("" : "+v"(tid_)); \
    _Pragma("unroll") for (int i_ = 0; i_ < NI_; ++i_) { const int q_ = tid_ + NTHREADS * i_, e = q_ / CPR_, c16_ = q_ % CPR_; t_[i_] = *(const u32x4*)((ROWP) + c16_ * 8); } \
    _Pragma("unroll") for (int i_ = 0; i_ < NI_; ++i_) { const int q_ = tid_ + NTHREADS * i_, e = q_ / CPR_, c16_ = q_ % CPR_; \
        *(LAS u32x4*)((dstbase) + (c16_ >> 2) * 4096 + e * 64 + (((c16_ & 3) ^ ((e >> 2) & 3)) << 4)) = t_[i_]; } } while (0)
#define STAGE_K(dstbase, NROWS_MAX, nrows, ROWP) do { constexpr int NI_ = ((NROWS_MAX) * 8 + NTHREADS - 1) / NTHREADS; u32x4 t_[NI_]; int tid_ = C.tid; asm volatile("" : "+v"(tid_)); \
    _Pragma("unroll") for (int i_ = 0; i_ < NI_; ++i_) { int q_ = tid_ + NTHREADS * i_; q_ = q_ < (nrows) * 8 ? q_ : (nrows) * 8 - 1; const int row = q_ >> 3; t_[i_] = *(const u32x4*)((ROWP) + (q_ & 7) * 8); } \
    _Pragma("unroll") for (int i_ = 0; i_ < NI_; ++i_) { const int q_ = tid_ + NTHREADS * i_; if (q_ < (nrows) * 8) { const int row = q_ >> 3, c_ = q_ & 7; \
        *(LAS u32x4*)((dstbase) + row * 128 + ((c_ ^ ((row >> 1) & 7)) << 4)) = t_[i_]; } } } while (0)
#define STAGE_VT_SWZ(dstbase, NK, ROWP) do { constexpr int CPR_ = (NK) / 8, NI_ = 64 * CPR_ / NTHREADS; u32x4 t_[NI_]; int tid_ = C.tid; asm volatile("" : "+v"(tid_)); \
    _Pragma("unroll") for (int i_ = 0; i_ < NI_; ++i_) { const int q_ = tid_ + NTHREADS * i_, e = q_ / CPR_, c16_ = q_ % CPR_; t_[i_] = *(const u32x4*)((ROWP) + c16_ * 8); } \
    _Pragma("unroll") for (int i_ = 0; i_ < NI_; ++i_) { const int q_ = tid_ + NTHREADS * i_, e = q_ / CPR_, c16_ = q_ % CPR_; \
        *(LAS u32x4*)((dstbase) + e * ((NK) * 2) + ((c16_ ^ (e & 15)) << 4)) = t_[i_]; } } while (0)

__device__ __forceinline__ void r2w_ret_unit(const Ctx& C, int l, int uid) {
    const UnitInfo u = unit_info(uid);
    const bf16* P = WSP(bf16, WS_BIG); const bf16* VT = WSP(bf16, WS_HA + HA_VTR); const bf16* SST = WSP(bf16, WS_HA + HA_SST); bf16* MIX = WSP(bf16, WS_BIG + BIG_MIX_OFF);
    const lds_p LK = C.lds, LV = C.lds + 16384, LS = C.lds + 32768;
    { const bf16* kb = P + (size_t)u.rowbase * NIN + C_RK + u.h * 64;
      STAGE_K(LK, 128, 128, kb + (size_t)row * NIN);
      const bf16* sb = SST + ((size_t)(uid * 2)) * 4096;
      STAGE_K(LS, 128, 128, sb + (size_t)row * 64);
      const bf16* vb = vt_row(VT, u.lat, u.b, u.h, 0) + u.tpos;
      STAGE_VT_SWZ(LV, 128, vb + (size_t)e * u.T); }
    __syncthreads();
    const float lgf2 = log_sigmoid_f(INP(I_DECF)[l * 8 + u.h]) * LOG2E, lgb2 = log_sigmoid_f(INP(I_DECB)[l * 8 + u.h]) * LOG2E;
    const int fr = C.lane & 15, g = C.lane >> 4, qi = 16 * C.wave + fr, qrow = u.rowbase + qi;
    const bf16* qp = P + (size_t)qrow * NIN + C_RQ + u.h * 64 + 8 * g;
    const bf16x8 q0 = ld16(qp), q1 = ld16(qp + 32);
    f32x4 s[8];
#pragma unroll
    for (int jt = 0; jt < 8; ++jt) { f32x4 a = {0.f, 0.f, 0.f, 0.f}; a = MFMA16(ldsk(LK, 16 * jt + fr, g), q0, a); a = MFMA16(ldsk(LK, 16 * jt + fr, 4 + g), q1, a);
#pragma unroll
        for (int r = 0; r < 4; ++r) { const int dd = qi - (16 * jt + 4 * g + r);
            const float w = (dd >= 0 ? exp2f(lgf2 * (float)dd) : 0.f) + (dd <= 0 ? exp2f(lgb2 * (float)(-dd)) : 0.f); a[r] *= w; }
        s[jt] = a; }
    f32x4 o[4];
#pragma unroll
    for (int et = 0; et < 4; ++et) o[et] = (f32x4){0.f, 0.f, 0.f, 0.f};
#pragma unroll
    for (int kk = 0; kk < 4; ++kk) { const bf16x8 pb = pack8(s[2 * kk], s[2 * kk + 1]);
#pragma unroll
        for (int et = 0; et < 4; ++et) o[et] = MFMA16(ldsvt_swz(LV, 16 * et + fr, 256, 8 * kk + g), pb, o[et]); }
    const float qdf = exp2f(lgf2 * (float)(qi + 1)), qdb = exp2f(lgb2 * (float)(128 - qi));
#pragma unroll
    for (int et = 0; et < 4; ++et) { f32x4 cf = {0.f, 0.f, 0.f, 0.f}, cb = cf;
        cf = MFMA16(ldsk(LS, 16 * et + fr, g), q0, cf); cf = MFMA16(ldsk(LS, 16 * et + fr, 4 + g), q1, cf);
        cb = MFMA16(ldsk(LS, 64 + 16 * et + fr, g), q0, cb); cb = MFMA16(ldsk(LS, 64 + 16 * et + fr, 4 + g), q1, cb);
        o[et] += cf * qdf + cb * qdb; }
    float sum = 0.f;
#pragma unroll
    for (int et = 0; et < 4; ++et) sum += (o[et][0] + o[et][1]) + (o[et][2] + o[et][3]);
    const float mu = red4(sum) * (1.f / 64.f);
    float sq = 0.f;
#pragma unroll
    for (int et = 0; et < 4; ++et) { o[et] = o[et] - mu; sq += (o[et][0] * o[et][0] + o[et][1] * o[et][1]) + (o[et][2] * o[et][2] + o[et][3] * o[et][3]); }
    const float rstd = rsqrtf(red4(sq) * (1.f / 64.f) + EPS);
#pragma unroll
    for (int et = 0; et < 4; ++et) { const int e0 = u.h * 64 + 16 * et + 4 * g;
        const uint2 gw = *(const uint2*)(P + (size_t)qrow * NIN + C_RG + e0);
        const float g0 = __builtin_bit_cast(float, gw.x << 16), g1 = __builtin_bit_cast(float, gw.x & 0xffff0000u), g2 = __builtin_bit_cast(float, gw.y << 16), g3 = __builtin_bit_cast(float, gw.y & 0xffff0000u);
        uint2 w; w.x = pk2(o[et][0] * rstd * silu_f(g0), o[et][1] * rstd * silu_f(g1)); w.y = pk2(o[et][2] * rstd * silu_f(g2), o[et][3] * rstd * silu_f(g3));
        *(uint2*)(MIX + (size_t)qrow * DM + e0) = w; }
    __syncthreads();
}
__device__ __forceinline__ void r2w_ctx_unit(const Ctx& C, int id) {
    const int qh = id & 1, h = (id >> 1) & 7, b = id >> 4, fr = C.lane & 15, g = C.lane >> 4, rowbase = b * 256, qrow = rowbase + 128 * qh + 16 * C.wave + fr;
    const bf16* P = WSP(bf16, WS_BIG); const bf16* VT = WSP(bf16, WS_HA + HA_VTN); bf16* MIX = WSP(bf16, WS_BIG + BIG_MIX_OFF);
    const lds_p LK = C.lds, LV = C.lds + 32768;
    { const bf16* kb = P + (size_t)rowbase * NIN + C_NK + h * 64;
      STAGE_K(LK, 256, 256, kb + (size_t)row * NIN);
      const bf16* vb = vt_row(VT, 0, b, h, 0);
      STAGE_VT_SWZ(LV, 256, vb + (size_t)e * T_CTX); }
    __syncthreads();
    const bf16* qp = P + (size_t)qrow * NIN + C_NQ + h * 64 + 8 * g;
    const bf16x8 q0 = ld16(qp), q1 = ld16(qp + 32);
    f32x4 s[16];
#pragma unroll
    for (int jt = 0; jt < 16; ++jt) { f32x4 a = {0.f, 0.f, 0.f, 0.f}; a = MFMA16(ldsk(LK, 16 * jt + fr, g), q0, a); a = MFMA16(ldsk(LK, 16 * jt + fr, 4 + g), q1, a); s[jt] = a * LOG2E; }
    float m = -1e30f, lsum = 0.f; f32x4 o[4];
#pragma unroll
    for (int et = 0; et < 4; ++et) o[et] = (f32x4){0.f, 0.f, 0.f, 0.f};
    SOFTMAX_CHUNK(s, 16);
#pragma unroll
    for (int kk = 0; kk < 8; ++kk) { const bf16x8 pb = pack8(s[2 * kk], s[2 * kk + 1]);
#pragma unroll
        for (int et = 0; et < 4; ++et) o[et] = MFMA16(ldsvt_swz(LV, 16 * et + fr, 512, 8 * kk + g), pb, o[et]); }
    const float il = 1.f / lsum;
#pragma unroll
    for (int et = 0; et < 4; ++et) { uint2 w; w.x = pk2(o[et][0] * il, o[et][1] * il); w.y = pk2(o[et][2] * il, o[et][3] * il);
        *(uint2*)(MIX + (size_t)qrow * DM + 512 + h * 64 + 16 * et + 4 * g) = w; }
    __syncthreads();
}
struct NaTile { float m, lsum; f32x4 o[4]; bf16x8 q0, q1; };
struct NaGeom { int b, h, rg, latbase, urow0, nru, r, jbl, rs, krel0, fr, g; };
template <int HF>
__device__ __forceinline__ void na_local_half(const Ctx& C, int l, const NaGeom& G, NaTile& T) {
    const bf16* P = WSP(bf16, WS_BIG); const bf16* VT = WSP(bf16, WS_HA + HA_VTN); const float* rpb = INP(I_RPB) + (size_t)(l * 8 + G.h) * 15 * 31;
    const lds_p LK = C.lds, LV = C.lds + 63488; LAS float* LB = (LAS float*)(C.lds + 122880);
    constexpr int c0 = HF ? 24 : 0;
    const int jb = 2 * HF + G.jbl, qc = 16 * jb + G.fr, cs = min(max(qc - 8, 0), 48), qrow = G.latbase + G.r * 64 + qc, fr = G.fr, g = G.g;
    { const int nkeys = G.nru * 40; int tid_ = C.tid; asm volatile("" : "+v"(tid_));
      { constexpr int NI_ = (440 * 8 + NTHREADS - 1) / NTHREADS; u32x4 t_[NI_];
#pragma unroll
        for (int i_ = 0; i_ < NI_; ++i_) { int q_ = tid_ + NTHREADS * i_; q_ = q_ < nkeys * 8 ? q_ : nkeys * 8 - 1; const int key = q_ >> 3, kr = key / 40, cc = key - kr * 40;
            t_[i_] = *(const u32x4*)(P + (size_t)(G.latbase + (G.urow0 + kr) * 64 + c0 + cc) * NIN + C_NK + G.h * 64 + (q_ & 7) * 8); }
#pragma unroll
        for (int i_ = 0; i_ < NI_; ++i_) { const int q_ = tid_ + NTHREADS * i_; if (q_ < nkeys * 8) { const int key = q_ >> 3, c_ = q_ & 7;
            *(LAS u32x4*)(LK + key * 144 + c_ * 16) = t_[i_]; } } }
      { constexpr int NI_ = (64 * 55 + NTHREADS - 1) / NTHREADS; u32x4 t_[NI_]; const int cpe = G.nru * 5, tot = 64 * cpe;
#pragma unroll
        for (int i_ = 0; i_ < NI_; ++i_) { int q_ = tid_ + NTHREADS * i_; q_ = q_ < tot ? q_ : tot - 1; const int e = q_ / cpe, rem = q_ - e * cpe, kr = rem / 5, c5 = rem - kr * 5;
            t_[i_] = *(const u32x4*)(vt_row(VT, 1, G.b, G.h, e) + (G.urow0 + kr) * 64 + c0 + c5 * 8); }
#pragma unroll
        for (int i_ = 0; i_ < NI_; ++i_) { const int q_ = tid_ + NTHREADS * i_; if (q_ < tot) { const int e = q_ / cpe, rem = q_ - e * cpe, kr = rem / 5, c5 = rem - kr * 5;
            *(LAS u32x4*)(LV + kr * 5120 + e * 80 + c5 * 16) = t_[i_]; } } }
      if (HF == 0) for (int i_ = tid_; i_ < 497; i_ += NTHREADS) LB[i_] = (i_ >= 16 && i_ < 481) ? rpb[i_ - 16] : 0.f; }
    __syncthreads();
    { const bf16* qp = P + (size_t)qrow * NIN + C_NQ + G.h * 64 + 8 * g; T.q0 = ld16(qp); T.q1 = ld16(qp + 32); }
    f32x4 s[16];
#pragma unroll
    for (int tl = 0; tl < 16; ++tl) { const int kr = tl >> 1, hf2 = tl & 1, key0 = (G.krel0 + kr) * 40 + 8 * G.jbl + 16 * hf2;
        f32x4 a = {0.f, 0.f, 0.f, 0.f}; a = MFMA16(ldsk144(LK, key0 + fr, g), T.q0, a); a = MFMA16(ldsk144(LK, key0 + fr, 4 + g), T.q1, a);
#pragma unroll
        for (int rr = 0; rr < 4; ++rr) { const int kc = c0 + 8 * G.jbl + 16 * hf2 + 4 * g + rr; const bool ok = (kc >= cs) && (kc < cs + 16);
            const float bias = LB[16 + (G.rs + kr - G.r + 7) * 31 + (kc - qc + 15)];
            a[rr] = ok ? (a[rr] + bias) * LOG2E : -1e30f; }
        s[tl] = a; }
    float m = -1e30f, lsum = 0.f; f32x4 o[4];
#pragma unroll
    for (int et = 0; et < 4; ++et) o[et] = (f32x4){0.f, 0.f, 0.f, 0.f};
    SOFTMAX_CHUNK(s, 16);
#pragma unroll
    for (int kr = 0; kr < 8; ++kr) { const bf16x8 pb = pack8(s[2 * kr], s[2 * kr + 1]);
#pragma unroll
        for (int et = 0; et < 4; ++et) o[et] = MFMA16(ldsvt_lin(LV + (G.krel0 + kr) * 5120, 16 * et + fr, 80, 8 * G.jbl + 4 * g), pb, o[et]); }
    T.m = m; T.lsum = lsum;
#pragma unroll
    for (int et = 0; et < 4; ++et) T.o[et] = o[et];
    __syncthreads();
}
template <int HF>
__device__ __forceinline__ void na_ctx_half(const Ctx& C, const NaGeom& G, NaTile& T) {
    const lds_p CK = C.lds, CV = C.lds + 65536; bf16* MIX = WSP(bf16, WS_BIG + BIG_MIX_OFF);
    const int fr = G.fr, g = G.g;
    float m = T.m, lsum = T.lsum; f32x4 o[4];
#pragma unroll
    for (int et = 0; et < 4; ++et) o[et] = T.o[et];
#pragma unroll 1
    for (int n0 = 0; n0 < PAST; n0 += 256) {
        f32x4 s[16];
#pragma unroll
        for (int tl = 0; tl < 16; ++tl) { f32x4 a = {0.f, 0.f, 0.f, 0.f}; a = MFMA16(ldsk(CK, n0 + 16 * tl + fr, g), T.q0, a); a = MFMA16(ldsk(CK, n0 + 16 * tl + fr, 4 + g), T.q1, a); s[tl] = a * LOG2E; }
        SOFTMAX_CHUNK(s, 16);
#pragma unroll
        for (int kk = 0; kk < 8; ++kk) { const bf16x8 pb = pack8(s[2 * kk], s[2 * kk + 1]);
#pragma unroll
            for (int et = 0; et < 4; ++et) o[et] = MFMA16(ldsvt_blk(CV, n0 / 32 + kk, 16 * et + fr, g), pb, o[et]); }
    }
    const int qrow = G.latbase + G.r * 64 + 16 * (2 * HF + G.jbl) + fr; const float il = 1.f / lsum;
#pragma unroll
    for (int et = 0; et < 4; ++et) { uint2 w; w.x = pk2(o[et][0] * il, o[et][1] * il); w.y = pk2(o[et][2] * il, o[et][3] * il);
        *(uint2*)(MIX + (size_t)qrow * DM + 512 + G.h * 64 + 16 * et + 4 * g) = w; }
}
__device__ __forceinline__ void r2w_na_unit(const Ctx& C, int l, int id) {
    NaGeom G; G.rg = id & 15; G.h = (id >> 4) & 7; G.b = id >> 7; G.fr = C.lane & 15; G.g = C.lane >> 4;
    G.latbase = M_CTX + G.b * 4096;
    G.urow0 = min(max(4 * G.rg - 4, 0), 56); G.nru = min(max(4 * G.rg + 3 - 4, 0), 56) + 8 - G.urow0;
    G.r = 4 * G.rg + (C.wave >> 1); G.jbl = C.wave & 1; G.rs = min(max(G.r - 4, 0), 56); G.krel0 = G.rs - G.urow0;
    NaTile T0, T1;
    na_local_half<0>(C, l, G, T0);
    na_local_half<1>(C, l, G, T1);
    { const bf16* CKB = WSP(bf16, WS_CKB); const bf16* CVT = WSP(bf16, WS_CVT); const lds_p CK = C.lds, CV = C.lds + 65536;
      const bf16* kb = CKB + ((size_t)(((G.b * 2 + l) * 8 + G.h) * PAST)) * 64;
      STAGE_K(CK, 512, 512, kb + (size_t)row * 64);
      const bf16* vb = CVT + ((size_t)(((G.b * 2 + l) * 8 + G.h) * 64)) * PAST;
      STAGE_VT_BLK(CV, 512, vb + (size_t)e * PAST); }
    __syncthreads();
    na_ctx_half<0>(C, G, T0);
    na_ctx_half<1>(C, G, T1);
    __syncthreads();
}
__device__ __forceinline__ void ph_r2w(const Ctx& C, int l) {
    for (int uid = C.vcu; uid < N_UNITS; uid += C.G) r2w_ret_unit(C, l, uid);
    for (int id = C.vcu; id < NB_CTX * 8 * 2; id += C.G) r2w_ctx_unit(C, id);
    for (int id = C.vcu; id < NB_LAT * 8 * 16; id += C.G) r2w_na_unit(C, l, id);
}
enum { PH_PRO = 0, PH_H0 = 1, PH_L0 = 2, PH_PER_LAYER = 10, PH_END = PH_L0 + NLAYER * PH_PER_LAYER };
enum { LP_GIN = 0, LP_R1 = 1, LP_R1B = 2, LP_R2 = 3, LP_GOUT = 4, LP_N1 = 5, LP_GUP = 6, LP_CG = 7, LP_GDOWN = 8, LP_N2 = 9 };
#ifndef REP_MASK
#define REP_MASK 0
#endif
__global__ void __launch_bounds__(NTHREADS, 2) mk_fwd(Args a) {
    extern __shared__ __attribute__((aligned(16))) unsigned char lds_raw[];
    Ctx C;
    C.lds = (LAS unsigned char*)lds_raw;
    for (int u = threadIdx.x; u < (LDS_BYTES - LDSCTL_OFF) / 4; u += NTHREADS) ((LAS unsigned*)(C.lds + LDSCTL_OFF))[u] = 0u;
    __syncthreads();
    const bool multi = (a.ph_hi - a.ph_lo) > 1;
    XcdBarrier bar; bar.bar = (unsigned*)(a.ws + WS_CTL) + CW_BAR; bar.x = 0; bar.st = nullptr;
    if (multi) bar = xcd_barrier_post((unsigned*)(a.ws + WS_CTL) + CW_BAR, (volatile LAS unsigned*)(C.lds + MISC_OFF) + 8);


    for (int ph = a.ph_lo; ph < a.ph_hi; ++ph) {
      const int nrep_ = (ph >= PH_L0 && ((REP_MASK >> ((ph - PH_L0) % PH_PER_LAYER)) & 1)) ? 2 : 1;
      for (int rep_ = 0; rep_ < nrep_; ++rep_) {
        if (rep_) xcd_barrier(bar);
        { KArgs kp = (KArgs)__builtin_amdgcn_kernarg_segment_ptr(); asm volatile("" : "+s"(kp)); C.ap = kp;
          int t = threadIdx.x; asm volatile("" : "+v"(t)); C.tid = t; C.lane = t & 63; C.wave = __builtin_amdgcn_readfirstlane(t >> 6);
          int bx = blockIdx.x; asm volatile("" : "+s"(bx)); C.bx = bx; C.G = gridDim.x; C.vcu = (C.G % 8 == 0) ? (bx % 8) * (C.G / 8) + bx / 8 : bx; }
        if (ph == PH_PRO) { ph_prologue(C); ph_cache_prep(C); }
        else if (ph == PH_H0) ph_norm_in(C);
        else {
            const int l = (ph - PH_L0) / PH_PER_LAYER, lp = (ph - PH_L0) % PH_PER_LAYER;
            unsigned char* ws = C.ap->ws; unsigned char* wl = ws + WS_W + (size_t)l * W_LAYER_BYTES;
            if (lp == LP_GIN) {
                pg8::Gemm g{(const bf16*)(ws + WS_HA), (const bf16*)(wl + W_IN_OFF), MROWS, NIN, DM}; pg8::StaticOrder S; S.init(MROWS, NIN, C.G, C.bx);
                EpiInF E{(bf16*)(ws + WS_BIG), C.ap->out, l};
                pg8::gemm_phase<EpiInF, pg8::StaticOrder, true, true>(C.lds, g, S, E, C.tid);
            } else if (lp == LP_R1) ph_r1(C, l);
            else if (lp == LP_R1B) ph_r1b(C, l);
            else if (lp == LP_R2) ph_r2w(C, l);
            else if (lp == LP_GOUT) {
                pg8::Gemm g{(const bf16*)(ws + WS_BIG + BIG_MIX_OFF), (const bf16*)(wl + W_OUT_OFF), MROWS, DM, DM}; pg8::StaticOrder S; S.init(MROWS, DM, C.G, C.bx);
                EpiF32F E{(float*)(ws + WS_BIG), DM};
                pg8::gemm_phase<EpiF32F, pg8::StaticOrder, true, true>(C.lds, g, S, E, C.tid);
            } else if (lp == LP_N1) ph_post_norm(C, l, 0);
            else if (lp == LP_GUP) {
                pg8::Gemm g{(const bf16*)(ws + WS_HA), (const bf16*)(wl + W_UP_OFF), MROWS, NUP, DM}; pg8::StaticOrder S; S.init(MROWS, NUP, C.G, C.bx);
                EpiBfF E{(bf16*)(ws + WS_BIG), NUP};
                pg8::gemm_phase<EpiBfF, pg8::StaticOrder, true, true>(C.lds, g, S, E, C.tid);
            } else if (lp == LP_CG) ph_convgate(C, l);
            else if (lp == LP_GDOWN) {
                pg8::Gemm g{(const bf16*)(ws + WS_HA), (const bf16*)(wl + W_DOWN_OFF), MROWS, DM, NFF}; pg8::StaticOrder S; S.init(MROWS, DM, C.G, C.bx);
                EpiF32F E{(float*)(ws + WS_BIG), DM};
                pg8::gemm_phase<EpiF32F, pg8::StaticOrder, true, true>(C.lds, g, S, E, C.tid);
            } else if (lp == LP_N2) ph_post_norm(C, l, 1);
        }
      }
        if (ph + 1 < a.ph_hi) xcd_barrier(bar);
    }
}

extern "C" void kernel_launch(void* const* d_in, const int* in_sizes, int n_in, void* d_out, int out_size, void* d_ws, size_t ws_size, hipStream_t stream) {
    static int grid = 0;
    if (grid == 0) {
        if (ws_size < WS_NEED || n_in != 23) { fprintf(stderr, "kernel_launch: unexpected sizes (ws %zu, n_in %d)\n", ws_size, n_in); grid = -1; return; }
        int dev = 0, cus = 0, per_cu = 0;
        if (hipGetDevice(&dev) != hipSuccess || hipDeviceGetAttribute(&cus, hipDeviceAttributeMultiprocessorCount, dev) != hipSuccess) { grid = -1; return; }
        if (hipFuncSetAttribute((const void*)mk_fwd, hipFuncAttributeMaxDynamicSharedMemorySize, LDS_BYTES) != hipSuccess) { fprintf(stderr, "kernel_launch: hipFuncSetAttribute failed\n"); grid = -1; return; }
        if (hipOccupancyMaxActiveBlocksPerMultiprocessor(&per_cu, (const void*)mk_fwd, NTHREADS, LDS_BYTES) != hipSuccess || per_cu < 1) { fprintf(stderr, "kernel_launch: occupancy query says %d\n", per_cu); per_cu = 1; }
        (void)hipGetLastError();
        grid = cus;
    }
    if (grid < 0) return;
    const float* x_prompt = (const float*)d_in[0]; const float* x_sample = (const float*)d_in[1];
    const float* cache_k = (const float*)d_in[3]; const float* cache_v = (const float*)d_in[4]; const float* st_f = (const float*)d_in[5]; const float* st_b = (const float*)d_in[6];
    const float* dec_f = (const float*)d_in[15]; const float* dec_b = (const float*)d_in[16]; const float* rpb = (const float*)d_in[17];
    float* out = (float*)d_out; unsigned char* ws = (unsigned char*)d_ws;
    bf16* P = (bf16*)(ws + WS_BIG); bf16* MIX = (bf16*)(ws + WS_BIG + BIG_MIX_OFF);
    (void)x_prompt; (void)x_sample; (void)cache_k; (void)cache_v; (void)st_f; (void)st_b; (void)dec_f; (void)dec_b; (void)rpb; (void)P; (void)MIX;
    (void)hipMemsetAsync(ws + WS_CTL, 0, CTL_BYTES, stream);
    Args a{};
    for (int i = 0; i < 23; ++i) a.in[i] = (const float*)d_in[i];
    a.out = out; a.ws = ws;
    auto run = [&](int lo, int hi) { a.ph_lo = lo; a.ph_hi = hi; hipLaunchKernelGGL(mk_fwd, dim3(grid), dim3(NTHREADS), LDS_BYTES, stream, a); };
    run(PH_PRO, PH_END);
}
```
